# Optimizing an MI355X kernel written in HIP

```python
import math
import jax
import jax.numpy as jnp
from jax import lax
import numpy as np

D_MODEL = 2048
BATCH = 4
SEQ = 2048
DEPTH = 1

MIX_WIDTH = D_MODEL
GDN_HEADS = 8
GDN_HEAD_DIM = 128
GDN_WIDTH = GDN_HEADS * GDN_HEAD_DIM
GDN_CONV = 4
GDN_CHUNK = 64
MOBA_HEADS = 8
MOBA_HEAD_DIM = (MIX_WIDTH - GDN_WIDTH) // MOBA_HEADS
MOBA_WIDTH = MOBA_HEADS * MOBA_HEAD_DIM
MOBA_BLOCK = 256
MOBA_TOPK = 3
MOBA_Q_CHUNK = 32
ROPE_DIM = MOBA_HEAD_DIM // 4
ROPE_THETA = 500000.0
D_FF = 256 * ((8 * D_MODEL // 3 + 255) // 256)
N_MOD = 9
NORM_EPS = 1e-6
IN_COLS = 4 * GDN_WIDTH + 2 * GDN_HEADS + 3 * MOBA_WIDTH

kernel_name = "hymba_gdn_moba_macaron_adaln_block"


def rms_norm(x, g):
    xf = x.astype(jnp.float32)
    y = xf * lax.rsqrt(jnp.mean(xf * xf, axis=-1, keepdims=True) + NORM_EPS)
    return (y * g.astype(jnp.float32)).astype(x.dtype)


def l2_normalize(x):
    return x * lax.rsqrt(jnp.sum(x * x, axis=-1, keepdims=True) + NORM_EPS)


def swiglu(h, w_gate, w_up, w_down):
    return (jax.nn.silu(h @ w_gate) * (h @ w_up)) @ w_down


def causal_depthwise_conv(x, w):
    K = w.shape[0]
    S = x.shape[1]
    xp = jnp.pad(x, ((0, 0), (K - 1, 0), (0, 0)))
    y = xp[:, 0:S] * w[0]
    for j in range(1, K):
        y = y + xp[:, j:j + S] * w[j]
    return y


def partial_rope(x, pos):
    inv_freq = ROPE_THETA ** (-jnp.arange(0, ROPE_DIM, 2, dtype=jnp.float32) / ROPE_DIM)
    ang = pos.astype(jnp.float32)[:, None] * inv_freq[None, :]
    cos, sin = jnp.cos(ang), jnp.sin(ang)
    x_rot, x_pass = x[..., :ROPE_DIM], x[..., ROPE_DIM:]
    half = ROPE_DIM // 2
    x1 = x_rot[..., :half].astype(jnp.float32)
    x2 = x_rot[..., half:].astype(jnp.float32)
    rot = jnp.concatenate([x1 * cos - x2 * sin, x2 * cos + x1 * sin], axis=-1)
    return jnp.concatenate([rot.astype(x.dtype), x_pass], axis=-1)


def chunked_gated_delta_rule(q, k, v, g, beta):
    B, H, S, dk = q.shape
    dv = v.shape[-1]
    C = GDN_CHUNK
    S_pad = -(-S // C) * C
    pad = S_pad - S
    q, k, v = [jnp.pad(t, ((0, 0), (0, 0), (0, pad), (0, 0))) for t in (q, k, v)]
    g, beta = [jnp.pad(t, ((0, 0), (0, 0), (0, pad))) for t in (g, beta)]
    N = S_pad // C
    q = q * (dk ** -0.5)
    qc = q.reshape(B, H, N, C, dk)
    kc = k.reshape(B, H, N, C, dk)
    vc = v.reshape(B, H, N, C, dv)
    bc = beta.reshape(B, H, N, C)
    G = jnp.cumsum(g.reshape(B, H, N, C), axis=-1)
    tril = jnp.tril(jnp.ones((C, C), dtype=bool))
    strict = jnp.tril(jnp.ones((C, C), dtype=bool), -1)
    decay = jnp.exp(jnp.where(tril, G[..., :, None] - G[..., None, :], -jnp.inf))
    k_beta = kc * bc[..., None]
    v_beta = vc * bc[..., None]
    L = jnp.where(strict, jnp.einsum('bhnid,bhnjd->bhnij', k_beta, kc) * decay, 0.0)
    u = lax.linalg.triangular_solve(L, v_beta, left_side=True, lower=True, unit_diagonal=True)
    w = lax.linalg.triangular_solve(L, k_beta * jnp.exp(G)[..., None], left_side=True, lower=True,
                                    unit_diagonal=True)
    attn_intra = jnp.where(tril, jnp.einsum('bhnid,bhnjd->bhnij', qc, kc) * decay, 0.0)

    def step(state, inp):
        q_i, k_i, u_i, w_i, G_i, A_i = inp
        v_new = u_i - jnp.einsum('bhck,bhkv->bhcv', w_i, state)
        o_i = (jnp.einsum('bhck,bhkv->bhcv', q_i * jnp.exp(G_i)[..., None], state)
               + jnp.einsum('bhcj,bhjv->bhcv', A_i, v_new))
        g_last = G_i[..., -1]
        k_dec = k_i * jnp.exp(g_last[..., None] - G_i)[..., None]
        state = state * jnp.exp(g_last)[..., None, None] + jnp.einsum('bhck,bhcv->bhkv', k_dec, v_new)
        return state, o_i

    xs = tuple(jnp.moveaxis(t, 2, 0) for t in (qc, kc, u, w, G, attn_intra))
    state0 = jnp.zeros((B, H, dk, dv), jnp.float32)
    _, o = lax.scan(step, state0, xs)
    o = jnp.moveaxis(o, 0, 2).reshape(B, H, S_pad, dv)
    return o[:, :, :S]


def gated_deltanet(q, k, v, z, a, b, conv_w, a_log, dt_bias, norm_g):
    B, S, _ = q.shape
    dtype = q.dtype
    qkv = jax.nn.silu(causal_depthwise_conv(jnp.concatenate([q, k, v], axis=-1), conv_w))
    q, k, v = jnp.split(qkv.astype(jnp.float32), 3, axis=-1)
    to_heads = lambda t: t.reshape(B, S, GDN_HEADS, GDN_HEAD_DIM).transpose(0, 2, 1, 3)
    q = l2_normalize(to_heads(q))
    k = l2_normalize(to_heads(k))
    v = to_heads(v)
    beta = jax.nn.sigmoid(b.astype(jnp.float32)).transpose(0, 2, 1)
    g = (-jnp.exp(a_log.astype(jnp.float32))
         * jax.nn.softplus(a.astype(jnp.float32) + dt_bias.astype(jnp.float32))).transpose(0, 2, 1)
    o = chunked_gated_delta_rule(q, k, v, g, beta).transpose(0, 2, 1, 3)
    zf = z.astype(jnp.float32).reshape(B, S, GDN_HEADS, GDN_HEAD_DIM)
    o = rms_norm(o, norm_g) * jax.nn.silu(zf)
    return o.reshape(B, S, GDN_WIDTH).astype(dtype)


def moba_attention(q, k, v):
    B, H, S, hd = q.shape
    S_pad = -(-S // MOBA_BLOCK) * MOBA_BLOCK
    pad = S_pad - S
    q, k, v = [jnp.pad(t, ((0, 0), (0, 0), (0, pad), (0, 0))) for t in (q, k, v)]
    NB = S_pad // MOBA_BLOCK
    top = min(MOBA_TOPK, NB)
    kb = k.reshape(B, H, NB, MOBA_BLOCK, hd)
    vb = v.reshape(B, H, NB, MOBA_BLOCK, hd)
    kmean = jnp.mean(kb.astype(jnp.float32), axis=3)
    NQ = S_pad // MOBA_Q_CHUNK
    q_chunks = jnp.moveaxis(q.reshape(B, H, NQ, MOBA_Q_CHUNK, hd), 2, 0)
    bi = jnp.arange(B)[:, None, None, None]
    hi = jnp.arange(H)[None, :, None, None]
    scale = hd ** -0.5

    def one_chunk(args):
        q_i, ci = args
        qpos = ci * MOBA_Q_CHUNK + jnp.arange(MOBA_Q_CHUNK)
        own = (ci * MOBA_Q_CHUNK) // MOBA_BLOCK
        gate = jnp.einsum('bhqd,bhnd->bhqn', q_i.astype(jnp.float32), kmean)
        gate = jnp.where(jnp.arange(NB) < own, gate, -jnp.inf)
        _, sel = lax.top_k(gate, top)
        valid = jnp.arange(top) < own
        k_sel = kb[bi, hi, sel]
        v_sel = vb[bi, hi, sel]
        k_own = lax.dynamic_index_in_dim(kb, own, axis=2, keepdims=False)
        v_own = lax.dynamic_index_in_dim(vb, own, axis=2, keepdims=False)
        s_sel = jnp.einsum('bhqd,bhqtkd->bhqtk', q_i, k_sel).astype(jnp.float32) * scale
        s_sel = jnp.where(valid[:, None], s_sel, -jnp.inf)
        kpos = own * MOBA_BLOCK + jnp.arange(MOBA_BLOCK)
        s_own = jnp.einsum('bhqd,bhkd->bhqk', q_i, k_own).astype(jnp.float32) * scale
        s_own = jnp.where(kpos[None, :] <= qpos[:, None], s_own, -jnp.inf)
        s = jnp.concatenate([s_sel.reshape(B, H, MOBA_Q_CHUNK, top * MOBA_BLOCK), s_own], axis=-1)
        p = jax.nn.softmax(s, axis=-1).astype(v.dtype)
        p_sel = p[..., :top * MOBA_BLOCK].reshape(B, H, MOBA_Q_CHUNK, top, MOBA_BLOCK)
        p_own = p[..., top * MOBA_BLOCK:]
        return (jnp.einsum('bhqtk,bhqtkd->bhqd', p_sel, v_sel)
                + jnp.einsum('bhqk,bhkd->bhqd', p_own, v_own))

    out = lax.map(one_chunk, (q_chunks, jnp.arange(NQ)))
    out = jnp.moveaxis(out, 0, 2).reshape(B, H, S_pad, hd)
    return out[:, :, :S]


def hybrid_mixer(h, w_in, w_out, conv_w, a_log, dt_bias, norm_g, pos):
    B, S, _ = h.shape
    proj = h @ w_in
    sizes = [GDN_WIDTH] * 4 + [GDN_HEADS] * 2 + [MOBA_WIDTH] * 3
    cuts = [int(v) for v in np.cumsum(sizes)[:-1]]
    gq, gk, gv, gz, ga, gb, mq, mk, mv = jnp.split(proj, cuts, axis=-1)
    y_gdn = gated_deltanet(gq, gk, gv, gz, ga, gb, conv_w, a_log, dt_bias, norm_g)
    to_heads = lambda t: t.reshape(B, S, MOBA_HEADS, MOBA_HEAD_DIM).transpose(0, 2, 1, 3)
    mq = partial_rope(to_heads(mq), pos)
    mk = partial_rope(to_heads(mk), pos)
    y_moba = moba_attention(mq, mk, to_heads(mv)).transpose(0, 2, 1, 3).reshape(B, S, MOBA_WIDTH)
    return jnp.concatenate([y_gdn, y_moba.astype(y_gdn.dtype)], axis=-1) @ w_out


def setup_inputs(seed: int = 0) -> dict:
    key = jax.random.key(seed)
    ks = jax.random.split(key, 24)
    f32 = jnp.float32

    def dense(k, fan_in, shape, gain=1.0):
        return jax.random.normal(k, shape, f32) * (gain * fan_in ** -0.5)

    def gain_vec(k, n):
        return 1.0 + 0.1 * jax.random.normal(k, (DEPTH, n), f32)

    x = jax.random.normal(ks[0], (BATCH, SEQ, D_MODEL), f32)
    c = jax.random.normal(ks[1], (BATCH, D_MODEL), f32)
    w_ada = dense(ks[2], D_MODEL, (DEPTH, D_MODEL, N_MOD * D_MODEL), 0.5)
    b_ada = 0.02 * jax.random.normal(ks[3], (DEPTH, N_MOD * D_MODEL), f32)
    ffn1_pre_g = gain_vec(ks[4], D_MODEL)
    ffn1_post_g = gain_vec(ks[5], D_MODEL)
    ffn1_w_gate = dense(ks[6], D_MODEL, (DEPTH, D_MODEL, D_FF))
    ffn1_w_up = dense(ks[7], D_MODEL, (DEPTH, D_MODEL, D_FF))
    ffn1_w_down = dense(ks[8], D_FF, (DEPTH, D_FF, D_MODEL))
    mix_pre_g = gain_vec(ks[9], D_MODEL)
    mix_post_g = gain_vec(ks[10], D_MODEL)
    w_in = dense(ks[11], D_MODEL, (DEPTH, D_MODEL, IN_COLS))
    gdn_conv_w = dense(ks[12], GDN_CONV, (DEPTH, GDN_CONV, 3 * GDN_WIDTH))
    gdn_a_log = jnp.log(jax.random.uniform(ks[13], (DEPTH, GDN_HEADS), f32, 1.0, 16.0))
    dt = jnp.exp(jax.random.uniform(ks[14], (DEPTH, GDN_HEADS), f32, math.log(1e-3), math.log(1e-1)))
    gdn_dt_bias = dt + jnp.log(-jnp.expm1(-dt))
    gdn_norm_g = gain_vec(ks[15], GDN_HEAD_DIM)
    w_out = dense(ks[16], MIX_WIDTH, (DEPTH, MIX_WIDTH, D_MODEL))
    ffn2_pre_g = gain_vec(ks[17], D_MODEL)
    ffn2_post_g = gain_vec(ks[18], D_MODEL)
    ffn2_w_gate = dense(ks[19], D_MODEL, (DEPTH, D_MODEL, D_FF))
    ffn2_w_up = dense(ks[20], D_MODEL, (DEPTH, D_MODEL, D_FF))
    ffn2_w_down = dense(ks[21], D_FF, (DEPTH, D_FF, D_MODEL))
    return {"x": x, "c": c, "w_ada": w_ada, "b_ada": b_ada,
            "ffn1_pre_g": ffn1_pre_g, "ffn1_post_g": ffn1_post_g,
            "ffn1_w_gate": ffn1_w_gate, "ffn1_w_up": ffn1_w_up, "ffn1_w_down": ffn1_w_down,
            "mix_pre_g": mix_pre_g, "mix_post_g": mix_post_g, "w_in": w_in,
            "gdn_conv_w": gdn_conv_w, "gdn_a_log": gdn_a_log, "gdn_dt_bias": gdn_dt_bias,
            "gdn_norm_g": gdn_norm_g, "w_out": w_out,
            "ffn2_pre_g": ffn2_pre_g, "ffn2_post_g": ffn2_post_g,
            "ffn2_w_gate": ffn2_w_gate, "ffn2_w_up": ffn2_w_up, "ffn2_w_down": ffn2_w_down}


def reference(x, c, w_ada, b_ada, ffn1_pre_g, ffn1_post_g, ffn1_w_gate, ffn1_w_up, ffn1_w_down,
              mix_pre_g, mix_post_g, w_in, gdn_conv_w, gdn_a_log, gdn_dt_bias, gdn_norm_g, w_out,
              ffn2_pre_g, ffn2_post_g, ffn2_w_gate, ffn2_w_up, ffn2_w_down):
    B, S, _ = x.shape
    pos = jnp.arange(S)
    for l in range(DEPTH):
        mod = (jax.nn.silu(c) @ w_ada[l] + b_ada[l]).reshape(B, N_MOD, D_MODEL)[:, :, None, :]
        sh1, sc1, ga1, sh2, sc2, ga2, sh3, sc3, ga3 = [mod[:, i] for i in range(N_MOD)]
        h = rms_norm(x, ffn1_pre_g[l]) * (1 + sc1) + sh1
        y = swiglu(h, ffn1_w_gate[l], ffn1_w_up[l], ffn1_w_down[l])
        x = x + 0.5 * ga1 * rms_norm(y, ffn1_post_g[l])
        h = rms_norm(x, mix_pre_g[l]) * (1 + sc2) + sh2
        y = hybrid_mixer(h, w_in[l], w_out[l], gdn_conv_w[l], gdn_a_log[l], gdn_dt_bias[l],
                         gdn_norm_g[l], pos)
        x = x + ga2 * rms_norm(y, mix_post_g[l])
        h = rms_norm(x, ffn2_pre_g[l]) * (1 + sc3) + sh3
        y = swiglu(h, ffn2_w_gate[l], ffn2_w_up[l], ffn2_w_down[l])
        x = x + 0.5 * ga3 * rms_norm(y, ffn2_post_g[l])
    return x
```

```cpp
#include <hip/hip_runtime.h>
#include <cstdio>
#include <cstdint>
#include <cmath>
namespace pg8 {
#define PG8_LAS __attribute__((address_space(3)))
typedef unsigned short bf16_t;
typedef short bf16x8 __attribute__((ext_vector_type(8)));
typedef float f32x4 __attribute__((ext_vector_type(4)));
typedef unsigned u32x4 __attribute__((ext_vector_type(4)));
constexpr int BM = 256, BK = 64, HALF = 128, HTB = HALF * BK * 2  , STAGE_BYTES = 8 * HTB, NXCD = 8, WGM = 8;

__host__ __device__ __forceinline__ int lds_byte(int r, int c) { const int st = (r >> 4) * 2 + (c >> 5), rr = r & 15, cc = c & 31, ob = rr * 64 + cc * 2; return st * 1024 + (ob ^ (((ob >> 9) & 1) << 5)); }
__host__ __device__ __forceinline__ void stage_rc(int b, int& R, int& C) { const int st = b / 1024, sb = b % 1024, swz = sb ^ (((sb >> 9) & 1) << 5); R = (st >> 1) * 16 + swz / 64; C = (st & 1) * 32 + (swz % 64) / 2; }
__host__ __device__ __forceinline__ int perm32(int rho) { const int n = rho >> 4, i = rho & 15; return 8 * (i >> 2) + 4 * n + (i & 3); }

struct Unit { int pm, pn; };
struct Gemm { const bf16_t* A; const bf16_t* Bt; int M, N, K; };

struct StaticOrder {
    int nM, nN, nwg, G, c;
    __host__ __device__ void init(int M, int N, int G_, int c_) { nM = M / BM; nN = N / BM; nwg = nM * nN; G = G_; c = c_; }
    __host__ __device__ bool next(int i, Unit& u) const {
        const long L = (long)i * G + c; if (L >= nwg) return false;
        int wgid = (int)L; { const int q = nwg / NXCD, r = nwg % NXCD, xcd = wgid % NXCD, off = wgid / NXCD; wgid = (xcd < r ? xcd * (q + 1) : r * (q + 1) + (xcd - r) * q) + off; }
        const int nig = WGM * nN, gid = wgid / nig, fm = gid * WGM, gsz = (nM - fm) < WGM ? (nM - fm) : WGM;
        u.pm = fm + ((wgid % nig) % gsz); u.pn = (wgid % nig) / gsz; return true;
    }
    __device__ __forceinline__ void a_ready(const Unit&) const {}
    __device__ __forceinline__ void done(const Unit&) const {}
};


__device__ __forceinline__ unsigned cvt_pk_bf16(float lo, float hi) { unsigned r; asm volatile("v_cvt_pk_bf16_f32 %0, %1, %2" : "=v"(r) : "v"(lo), "v"(hi)); return r; }
__device__ __forceinline__ float silu_f(float g) { return g * __builtin_amdgcn_rcpf(1.0f + __builtin_amdgcn_exp2f(g * -1.4426950408889634f)); }

struct EpiBf16 {
    static constexpr bool PERM = true, AFTER_DRAIN = false;
    bf16_t* O; int ldc;
    __device__ __forceinline__ void operator()(const f32x4 (&acc)[2][2][4][2], const Unit& u, int wr, int wc, int fr, int fq) const {
        const int row0 = u.pm * BM + wr * 64 + fr; const int col0 = u.pn * BM + wc * 32 + 8 * fq;
#pragma unroll
        for (int ai = 0; ai < 2; ++ai)
#pragma unroll
            for (int m = 0; m < 4; ++m) { bf16_t* rowp = O + (size_t)(row0 + ai * HALF + m * 16) * ldc + col0;
#pragma unroll
                for (int bj = 0; bj < 2; ++bj) { const f32x4 v0 = acc[ai][bj][m][0], v1 = acc[ai][bj][m][1];
                    u32x4 w; w.x = cvt_pk_bf16(v0[0], v0[1]); w.y = cvt_pk_bf16(v0[2], v0[3]); w.z = cvt_pk_bf16(v1[0], v1[1]); w.w = cvt_pk_bf16(v1[2], v1[3]);
                    *(u32x4*)(rowp + bj * HALF) = w; } }
    }
};
struct EpiSwiGLU {
    static constexpr bool PERM = true, AFTER_DRAIN = false;
    bf16_t* O; int ldc;
    __device__ __forceinline__ void operator()(const f32x4 (&acc)[2][2][4][2], const Unit& u, int wr, int wc, int fr, int fq) const {
        const int row0 = u.pm * BM + wr * 64 + fr; const int col0 = u.pn * HALF + wc * 32 + 8 * fq;
#pragma unroll
        for (int ai = 0; ai < 2; ++ai)
#pragma unroll
            for (int m = 0; m < 4; ++m) { bf16_t* rowp = O + (size_t)(row0 + ai * HALF + m * 16) * ldc + col0;
                const f32x4 g0 = acc[ai][0][m][0], g1 = acc[ai][0][m][1], u0 = acc[ai][1][m][0], u1 = acc[ai][1][m][1];
                u32x4 w;
                w.x = cvt_pk_bf16(silu_f(g0[0]) * u0[0], silu_f(g0[1]) * u0[1]); w.y = cvt_pk_bf16(silu_f(g0[2]) * u0[2], silu_f(g0[3]) * u0[3]);
                w.z = cvt_pk_bf16(silu_f(g1[0]) * u1[0], silu_f(g1[1]) * u1[1]); w.w = cvt_pk_bf16(silu_f(g1[2]) * u1[2], silu_f(g1[3]) * u1[3]);
                *(u32x4*)rowp = w; }
    }
};
struct EpiF32 {
    static constexpr bool PERM = false, AFTER_DRAIN = false;
    float* C; int ldc;
    __device__ __forceinline__ void operator()(const f32x4 (&acc)[2][2][4][2], const Unit& u, int wr, int wc, int fr, int fq) const {
        const int row0 = u.pm * BM + wr * 64 + fr, col0 = u.pn * BM + wc * 32 + 4 * fq;
#pragma unroll
        for (int ai = 0; ai < 2; ++ai)
#pragma unroll
            for (int m = 0; m < 4; ++m) { float* rowp = C + (size_t)(row0 + ai * HALF + m * 16) * ldc + col0;
#pragma unroll
                for (int bj = 0; bj < 2; ++bj)
#pragma unroll
                    for (int n = 0; n < 2; ++n) *(f32x4*)(rowp + bj * HALF + n * 16) = acc[ai][bj][m][n]; }
    }
};
struct PanelSS {
    float* xbuf;
    unsigned* cnt;
    __device__ __forceinline__ void run(const f32x4 (&v)[2][2][4][2], const Unit& u, int wr, int wc, int fr, int fq, PG8_LAS unsigned char* lds, int wid, int lane) const {
        PG8_LAS float* P = (PG8_LAS float*)lds;
        PG8_LAS float* S = (PG8_LAS float*)(lds + 8192);
#pragma unroll
        for (int ai = 0; ai < 2; ++ai)
#pragma unroll
            for (int m = 0; m < 4; ++m) { float s = 0.f;
#pragma unroll
                for (int bj = 0; bj < 2; ++bj)
#pragma unroll
                    for (int n = 0; n < 2; ++n) { const f32x4 x = v[ai][bj][m][n]; s += (x[0] * x[0] + x[1] * x[1]) + (x[2] * x[2] + x[3] * x[3]); }
                s += __shfl_xor(s, 16); s += __shfl_xor(s, 32);
                if (fq == 0) P[(ai * HALF + wr * 64 + m * 16 + fr) * 4 + wc] = s; }
        asm volatile("s_waitcnt lgkmcnt(0)" ::: "memory"); __builtin_amdgcn_s_barrier(); asm volatile("" ::: "memory");
        const int row = wid * 32 + (lane & 31);
        if (lane < 32) { const float t = (P[row * 4 + 0] + P[row * 4 + 1]) + (P[row * 4 + 2] + P[row * 4 + 3]);
            __hip_atomic_store((unsigned*)xbuf + ((size_t)(u.pm * BM + row) * 8 + u.pn), __builtin_bit_cast(unsigned, t), __ATOMIC_RELAXED, __HIP_MEMORY_SCOPE_AGENT); }
        asm volatile("s_waitcnt vmcnt(0)" ::: "memory");
        if (lane == 0) __hip_atomic_fetch_add(cnt + 64 * u.pm, 1u, __ATOMIC_RELAXED, __HIP_MEMORY_SCOPE_AGENT);
        if (wid == 0) {
            unsigned sp = 0;
            while ((unsigned)__builtin_amdgcn_readfirstlane(__hip_atomic_load(cnt + 64 * u.pm, __ATOMIC_RELAXED, __HIP_MEMORY_SCOPE_AGENT)) < 64u) { __builtin_amdgcn_s_sleep(2); if (++sp > (1u << 22)) break; }
            __builtin_amdgcn_fence(__ATOMIC_ACQUIRE, "agent");
        }
        asm volatile("s_waitcnt vmcnt(0) lgkmcnt(0)" ::: "memory"); __builtin_amdgcn_s_barrier(); asm volatile("" ::: "memory");
        if (lane < 32) { const unsigned* slot = (const unsigned*)xbuf + (size_t)(u.pm * BM + row) * 8; float t = 0.f;
#pragma unroll
            for (int k = 0; k < 8; ++k) t += __builtin_bit_cast(float, __hip_atomic_load(slot + k, __ATOMIC_RELAXED, __HIP_MEMORY_SCOPE_AGENT));
            S[row] = t; }
        asm volatile("s_waitcnt lgkmcnt(0)" ::: "memory"); __builtin_amdgcn_s_barrier(); asm volatile("" ::: "memory");
    }
};
template <bool XIN_BF, bool XOUT_BF>
struct EpiNormRes {
    static constexpr bool PERM = true, AFTER_DRAIN = true;
    const void* xr; void* xo; bf16_t* Hout; const float* mod; const float* post_g; int i_ga; float gscale; const float* pre_g; int i_sh, i_sc; PanelSS st1, st2;
    __device__ __forceinline__ static void ldx(const void* base, size_t off, f32x4& a, f32x4& b) {
        if constexpr (XIN_BF) { const u32x4 w = *(const u32x4*)((const bf16_t*)base + off);
            a = (f32x4){__builtin_bit_cast(float, w.x << 16), __builtin_bit_cast(float, w.x & 0xffff0000u), __builtin_bit_cast(float, w.y << 16), __builtin_bit_cast(float, w.y & 0xffff0000u)};
            b = (f32x4){__builtin_bit_cast(float, w.z << 16), __builtin_bit_cast(float, w.z & 0xffff0000u), __builtin_bit_cast(float, w.w << 16), __builtin_bit_cast(float, w.w & 0xffff0000u)}; }
        else { a = *(const f32x4*)((const float*)base + off); b = *(const f32x4*)((const float*)base + off + 4); }
    }
    __device__ __forceinline__ void fused(f32x4 (&acc)[2][2][4][2], const Unit& u, int wr, int wc, int fr, int fq, PG8_LAS unsigned char* lds, int wid, int lane) const {
        const PG8_LAS float* S = (const PG8_LAS float*)(lds + 8192);
        const int col0 = u.pn * BM + wc * 32 + 8 * fq; const float* modb = mod + (size_t)(u.pm >> 3) * (9 * 2048);
        f32x4 pre[4][2][2];
#pragma unroll
        for (int m = 0; m < 4; ++m) { const size_t off = (size_t)(u.pm * BM + wr * 64 + m * 16 + fr) * 2048 + col0;
#pragma unroll
            for (int bj = 0; bj < 2; ++bj) ldx(xr, off + bj * HALF, pre[m][bj][0], pre[m][bj][1]); }
        st1.run(acc, u, wr, wc, fr, fq, lds, wid, lane);
        { f32x4 gg[2][2];
#pragma unroll
          for (int bj = 0; bj < 2; ++bj)
#pragma unroll
              for (int n = 0; n < 2; ++n) gg[bj][n] = (*(const f32x4*)(post_g + col0 + bj * HALF + n * 4)) * (*(const f32x4*)(modb + i_ga * 2048 + col0 + bj * HALF + n * 4)) * gscale;
#pragma unroll
          for (int ai = 0; ai < 2; ++ai)
#pragma unroll
              for (int m = 0; m < 4; ++m) { const int r = ai * HALF + wr * 64 + m * 16 + fr; const float rstd = 1.0f / sqrtf(S[r] * (1.0f / 2048.0f) + 1e-6f); const size_t off = (size_t)(u.pm * BM + r) * 2048 + col0;
#pragma unroll
                  for (int bj = 0; bj < 2; ++bj) { f32x4 x0, x1; if (ai == 0) { x0 = pre[m][bj][0]; x1 = pre[m][bj][1]; } else ldx(xr, off + bj * HALF, x0, x1);
                      f32x4 o0 = x0 + gg[bj][0] * (acc[ai][bj][m][0] * rstd), o1 = x1 + gg[bj][1] * (acc[ai][bj][m][1] * rstd);
                      if constexpr (XOUT_BF) { u32x4 w; w.x = cvt_pk_bf16(o0[0], o0[1]); w.y = cvt_pk_bf16(o0[2], o0[3]); w.z = cvt_pk_bf16(o1[0], o1[1]); w.w = cvt_pk_bf16(o1[2], o1[3]); *(u32x4*)((bf16_t*)xo + off + bj * HALF) = w;
                          o0 = (f32x4){__builtin_bit_cast(float, w.x << 16), __builtin_bit_cast(float, w.x & 0xffff0000u), __builtin_bit_cast(float, w.y << 16), __builtin_bit_cast(float, w.y & 0xffff0000u)};
                          o1 = (f32x4){__builtin_bit_cast(float, w.z << 16), __builtin_bit_cast(float, w.z & 0xffff0000u), __builtin_bit_cast(float, w.w << 16), __builtin_bit_cast(float, w.w & 0xffff0000u)}; }
                      else { *(f32x4*)((float*)xo + off + bj * HALF) = o0; *(f32x4*)((float*)xo + off + bj * HALF + 4) = o1; }
                      acc[ai][bj][m][0] = o0; acc[ai][bj][m][1] = o1; }
                  asm volatile("" : "+v"(acc[ai][0][m][0]), "+v"(acc[ai][0][m][1]), "+v"(acc[ai][1][m][0]), "+v"(acc[ai][1][m][1]));
                  if (ai == 0 && m == 3) asm volatile("" ::: "memory"); } }
        if (Hout) {
            st2.run(acc, u, wr, wc, fr, fq, lds, wid, lane);
            f32x4 ga[2][2], sh[2][2];
#pragma unroll
            for (int bj = 0; bj < 2; ++bj)
#pragma unroll
                for (int n = 0; n < 2; ++n) { ga[bj][n] = (*(const f32x4*)(pre_g + col0 + bj * HALF + n * 4)) * ((*(const f32x4*)(modb + i_sc * 2048 + col0 + bj * HALF + n * 4)) + 1.0f); sh[bj][n] = *(const f32x4*)(modb + i_sh * 2048 + col0 + bj * HALF + n * 4); }
#pragma unroll
            for (int ai = 0; ai < 2; ++ai)
#pragma unroll
                for (int m = 0; m < 4; ++m) { const int r = ai * HALF + wr * 64 + m * 16 + fr; const float rstd = 1.0f / sqrtf(S[r] * (1.0f / 2048.0f) + 1e-6f); const size_t off = (size_t)(u.pm * BM + r) * 2048 + col0;
#pragma unroll
                    for (int bj = 0; bj < 2; ++bj) { const f32x4 h0 = (acc[ai][bj][m][0] * rstd) * ga[bj][0] + sh[bj][0], h1 = (acc[ai][bj][m][1] * rstd) * ga[bj][1] + sh[bj][1];
                        u32x4 w; w.x = cvt_pk_bf16(h0[0], h0[1]); w.y = cvt_pk_bf16(h0[2], h0[3]); w.z = cvt_pk_bf16(h1[0], h1[1]); w.w = cvt_pk_bf16(h1[2], h1[3]); *(u32x4*)(Hout + off + bj * HALF) = w; }
                    if (m & 1) asm volatile("" ::: "memory"); }
        }
    }
};

template <class Epi, class Sched, bool ALIGN_EPI = false, bool SP2 = false>
__device__ __forceinline__ void gemm_phase(PG8_LAS unsigned char* lds, const Gemm g, const Sched& S, const Epi& E) {
    const int tid = threadIdx.x, wid = __builtin_amdgcn_readfirstlane(tid >> 6), lane = tid & 63, wr = wid >> 2, wc = wid & 3, fr = lane & 15, fq = lane >> 4;
    const int K = g.K, nt = K / BK;
    unsigned voffA[2], voffB[2];
#pragma unroll
    for (int i = 0; i < 2; ++i) { int R, C; stage_rc(tid * 16 + i * 8192, R, C); const int Rb = Epi::PERM ? ((R & ~31) + perm32(R & 31)) : R;
        voffA[i] = (unsigned)(R * K + C) * 2u; voffB[i] = (unsigned)(Rb * K + C) * 2u; }
    const size_t kstep = (size_t)(BK * 2);
    const size_t hstep = (size_t)HALF * K * 2;
    const size_t tstep = 2 * hstep;
    const unsigned ldsw = (unsigned)wid * 1024u;
    const int aoff = lds_byte(wr * 64 + fr, fq * 8), boff = lds_byte(wc * 32 + fr, fq * 8);
#define PG8_SA(b, h) (((b) * 2 + (h)) * HTB)
#define PG8_SB(b, h) ((4 + (b) * 2 + (h)) * HTB)
#define PG8_STAGE(bufoff, gbase, voff) do { _Pragma("unroll") for (int _i = 0; _i < 2; ++_i) \
        __builtin_amdgcn_global_load_lds((const unsigned*)((const char*)(gbase) + (voff)[_i]), (PG8_LAS unsigned*)(lds + (bufoff) + ldsw + _i * 8192), 16, 0, 0); } while (0)
#define PG8_LDA(dst, b, h) do { _Pragma("unroll") for (int m = 0; m < 4; ++m) _Pragma("unroll") for (int k = 0; k < 2; ++k) dst[m][k] = *(const PG8_LAS bf16x8*)(lds + PG8_SA(b, h) + aoff + m * 2048 + k * 1024); } while (0)
#define PG8_LDB(dst, b, h) do { _Pragma("unroll") for (int n = 0; n < 2; ++n) _Pragma("unroll") for (int k = 0; k < 2; ++k) dst[n][k] = *(const PG8_LAS bf16x8*)(lds + PG8_SB(b, h) + boff + n * 2048 + k * 1024); } while (0)
#define PG8_MMA(ai, bj, At, Bt) do { __builtin_amdgcn_s_setprio(1); _Pragma("unroll") for (int m = 0; m < 4; ++m) _Pragma("unroll") for (int n = 0; n < 2; ++n) _Pragma("unroll") for (int k = 0; k < 2; ++k) \
        acc[ai][bj][m][n] = __builtin_amdgcn_mfma_f32_16x16x32_bf16(Bt[n][k], At[m][k], acc[ai][bj][m][n], 0, 0, 0); __builtin_amdgcn_s_setprio(0); } while (0)
#define PG8_WAIT_V(n) asm volatile("s_waitcnt vmcnt(" #n ")" ::: "memory")
#define PG8_WAIT_L(n) asm volatile("s_waitcnt lgkmcnt(" #n ")" ::: "memory")
#define PG8_BAR __builtin_amdgcn_s_barrier()
#define PG8_SCHED __builtin_amdgcn_sched_barrier(0)
    Unit cur, nxt; int ui = 0;
    if (!S.next(0, cur)) return;
    f32x4 acc[2][2][4][2];
#pragma unroll
    for (int a = 0; a < 2; ++a)
#pragma unroll
        for (int b = 0; b < 2; ++b)
#pragma unroll
            for (int m = 0; m < 4; ++m)
#pragma unroll
                for (int n = 0; n < 2; ++n) acc[a][b][m][n] = (f32x4){0.f, 0.f, 0.f, 0.f};
    bf16x8 At[4][2], B0[2][2], B1[2][2];
    const char* cA = (const char*)g.A + (size_t)cur.pm * tstep; const char* cB = (const char*)g.Bt + (size_t)cur.pn * tstep;
    S.a_ready(cur);
    if constexpr (SP2) {
        PG8_STAGE(PG8_SB(0, 0), cB, voffB); PG8_STAGE(PG8_SB(0, 1), cB + hstep, voffB); PG8_STAGE(PG8_SA(0, 0), cA, voffA); PG8_STAGE(PG8_SA(0, 1), cA + hstep, voffA);
        if (wr == 1) PG8_BAR;
        PG8_WAIT_V(2); PG8_BAR;
        PG8_STAGE(PG8_SB(1, 0), cB + kstep, voffB); PG8_STAGE(PG8_SA(1, 0), cA + kstep, voffA); PG8_STAGE(PG8_SB(1, 1), cB + hstep + kstep, voffB);
        PG8_WAIT_V(6); PG8_BAR;
    } else {
        PG8_STAGE(PG8_SB(0, 0), cB, voffB); PG8_STAGE(PG8_SA(0, 0), cA, voffA); PG8_STAGE(PG8_SB(0, 1), cB + hstep, voffB); PG8_STAGE(PG8_SA(0, 1), cA + hstep, voffA);
        if (wr == 1) PG8_BAR;
        PG8_WAIT_V(4); PG8_BAR;
        PG8_STAGE(PG8_SB(1, 0), cB + kstep, voffB); PG8_STAGE(PG8_SA(1, 0), cA + kstep, voffA); PG8_STAGE(PG8_SB(1, 1), cB + hstep + kstep, voffB);
        PG8_WAIT_V(6); PG8_BAR;
    }
    for (;;) {
        const bool has_next = S.next(ui + 1, nxt);
        const char* nA = has_next ? (const char*)g.A + (size_t)nxt.pm * tstep : cA; const char* nB = has_next ? (const char*)g.Bt + (size_t)nxt.pn * tstep : cB;
        for (int t = 0; t < nt; t += 2) {
            const bool last = (t == nt - 2);
            const char* a1 = cA + (size_t)(t + 1) * kstep;
            const char* a2 = last ? nA : cA + (size_t)(t + 2) * kstep; const char* b2 = last ? nB : cB + (size_t)(t + 2) * kstep;
            const char* a3 = a2 + kstep; const char* b3 = b2 + kstep;
            if (last && has_next) S.a_ready(nxt);
            if constexpr (SP2) {
            PG8_LDB(B0, 0, 0); PG8_LDB(B1, 0, 1); PG8_SCHED; PG8_LDA(At, 0, 0); PG8_STAGE(PG8_SA(1, 1), a1 + hstep, voffA);
            PG8_WAIT_V(8); PG8_WAIT_L(0); PG8_BAR; PG8_MMA(0, 0, At, B0); PG8_MMA(0, 1, At, B1); PG8_BAR; PG8_SCHED;
            PG8_LDA(At, 0, 1); PG8_STAGE(PG8_SB(0, 0), b2, voffB); PG8_STAGE(PG8_SB(0, 1), b2 + hstep, voffB); PG8_STAGE(PG8_SA(0, 0), a2, voffA);
            PG8_WAIT_V(8); PG8_WAIT_L(0); PG8_BAR; PG8_MMA(1, 0, At, B0); PG8_MMA(1, 1, At, B1); PG8_BAR; PG8_SCHED;
            PG8_LDB(B0, 1, 0); PG8_LDB(B1, 1, 1); PG8_SCHED; PG8_LDA(At, 1, 0); PG8_STAGE(PG8_SA(0, 1), a2 + hstep, voffA);
            PG8_WAIT_V(8); PG8_WAIT_L(0); PG8_BAR; PG8_MMA(0, 0, At, B0); PG8_MMA(0, 1, At, B1); PG8_BAR; PG8_SCHED;
            PG8_LDA(At, 1, 1); PG8_STAGE(PG8_SB(1, 0), b3, voffB); PG8_STAGE(PG8_SB(1, 1), b3 + hstep, voffB); PG8_STAGE(PG8_SA(1, 0), a3, voffA);
            PG8_WAIT_V(8); PG8_WAIT_L(0); PG8_BAR; PG8_MMA(1, 0, At, B0); PG8_MMA(1, 1, At, B1); PG8_BAR; PG8_SCHED;
            } else {
            PG8_LDB(B0, 0, 0); PG8_SCHED; PG8_LDA(At, 0, 0); PG8_STAGE(PG8_SA(1, 1), a1 + hstep, voffA);
            PG8_WAIT_L(8); PG8_BAR; PG8_WAIT_L(0); PG8_MMA(0, 0, At, B0); PG8_BAR; PG8_SCHED;
            PG8_LDB(B1, 0, 1); PG8_STAGE(PG8_SB(0, 0), b2, voffB);
            PG8_BAR; PG8_WAIT_L(0); PG8_MMA(0, 1, At, B1); PG8_BAR;
            PG8_LDA(At, 0, 1); PG8_STAGE(PG8_SA(0, 0), a2, voffA);
            PG8_BAR; PG8_WAIT_L(0); PG8_MMA(1, 0, At, B0); PG8_BAR; PG8_SCHED;
            PG8_STAGE(PG8_SB(0, 1), b2 + hstep, voffB);
            PG8_WAIT_V(6); PG8_BAR; PG8_MMA(1, 1, At, B1); PG8_BAR;
            PG8_LDB(B0, 1, 0); PG8_SCHED; PG8_LDA(At, 1, 0); PG8_STAGE(PG8_SA(0, 1), a2 + hstep, voffA);
            PG8_WAIT_L(8); PG8_BAR; PG8_WAIT_L(0); PG8_MMA(0, 0, At, B0); PG8_BAR; PG8_SCHED;
            PG8_LDB(B1, 1, 1); PG8_STAGE(PG8_SB(1, 0), b3, voffB);
            PG8_BAR; PG8_WAIT_L(0); PG8_MMA(0, 1, At, B1); PG8_BAR;
            PG8_LDA(At, 1, 1); PG8_STAGE(PG8_SA(1, 0), a3, voffA);
            PG8_BAR; PG8_WAIT_L(0); PG8_MMA(1, 0, At, B0); PG8_BAR; PG8_SCHED;
            PG8_STAGE(PG8_SB(1, 1), b3 + hstep, voffB);
            PG8_WAIT_V(6); PG8_BAR; PG8_MMA(1, 1, At, B1); PG8_BAR;
            }
        }
        if constexpr (ALIGN_EPI) { if (wr == 0) PG8_BAR; }
        if constexpr (!Epi::AFTER_DRAIN) { E(acc, cur, wr, wc, fr, fq); S.done(cur); }
        if (!has_next) break;
#pragma unroll
        for (int a = 0; a < 2; ++a)
#pragma unroll
            for (int b = 0; b < 2; ++b)
#pragma unroll
                for (int m = 0; m < 4; ++m)
#pragma unroll
                    for (int n = 0; n < 2; ++n) acc[a][b][m][n] = (f32x4){0.f, 0.f, 0.f, 0.f};
        cur = nxt; cA = nA; cB = nB; ++ui;
        if constexpr (ALIGN_EPI) { if (wr == 1) PG8_BAR; }
    }
    PG8_WAIT_V(0);
    if constexpr (!ALIGN_EPI) { if (wr == 0) PG8_BAR; }
    PG8_BAR;
    if constexpr (Epi::AFTER_DRAIN) { E.fused(acc, cur, wr, wc, fr, fq, lds, wid, lane); S.done(cur); }
#undef PG8_SA
#undef PG8_SB
#undef PG8_STAGE
#undef PG8_LDA
#undef PG8_LDB
#undef PG8_MMA
#undef PG8_WAIT_V
#undef PG8_WAIT_L
#undef PG8_BAR
#undef PG8_SCHED
}
}

constexpr int NWAVES = 8, NTHR = 512;
constexpr int DM = 2048, NB = 4, SEQ = 2048, M = NB * SEQ, DFF = 5632, NGU = 2 * DFF, NIN = 7424, NMOD = 9, NMODC = NMOD * DM;
constexpr int INC = 7184;
constexpr int GDH = 8, HD = 128, GDW = 1024, CONVC = 3072;
constexpr float EPS = 1e-6f;
constexpr int PC_GZ = 3072, PC_MQ = 4096, PC_MK = 5120, PC_MV = 6144, PC_A = 7168, PC_B = 7176;

constexpr size_t MiB = 1u << 20;
constexpr size_t WS_CTL = 0, CTL_ZERO_BYTES = 1 * MiB;
constexpr size_t WS_MOD = 1 * MiB, WS_ROPE = 1 * MiB + 512 * 1024, WS_KMEAN = 1 * MiB + 768 * 1024, WS_GB = 2 * MiB;
constexpr size_t WS_WGU1 = 4 * MiB, WS_WD1 = 48 * MiB, WS_WIN = 70 * MiB, WS_WOUT = 99 * MiB, WS_WGU2 = 107 * MiB, WS_WD2 = 151 * MiB;
constexpr size_t WS_H = 176 * MiB, WS_ACT = 208 * MiB, WS_YMIX = 208 * MiB, WS_Y = 296 * MiB, WS_OG = 296 * MiB, WS_PROJ = 360 * MiB, WS_OPS = 476 * MiB, WS_UF = 532 * MiB, WS_GZ = 296 * MiB, WS_XRES = 328 * MiB, WS_DEC = 2 * MiB, WS_END = 572 * MiB;
constexpr int CW_TMO = 0, CW_CODE = 1, CW_ADA = 2048, CW_ADAC = 2560, CW_BAR = 4096, CW_PAN = 16384;
constexpr size_t WS_APART = 312 * MiB;
constexpr size_t WS_XB = 2 * MiB + 512 * 1024;

constexpr int RING_OFF = 0, RING_BYTES = 151552;
constexpr int LDSCTL_OFF = RING_BYTES, MISC_OFF = LDSCTL_OFF + 320;
constexpr int LDS_BYTES = 155648;

#define GAS __attribute__((address_space(1)))
#define LAS __attribute__((address_space(3)))
typedef unsigned short bf16;
typedef unsigned v4u __attribute__((ext_vector_type(4)));
typedef unsigned v2u __attribute__((ext_vector_type(2)));
typedef float f32x4 __attribute__((ext_vector_type(4)));
typedef float f32x2 __attribute__((ext_vector_type(2)));
typedef short bf16x8 __attribute__((ext_vector_type(8)));
typedef GAS unsigned gu32;
#define RLX_AGENT __ATOMIC_RELAXED, __HIP_MEMORY_SCOPE_AGENT
#define LDS_WAIT() asm volatile("s_waitcnt lgkmcnt(0)" ::: "memory")
#define VM_WAIT() asm volatile("s_waitcnt vmcnt(0)" ::: "memory")
__device__ __forceinline__ unsigned f2bf(float f) { unsigned u = __builtin_bit_cast(unsigned, f); return (u + 0x7fffu + ((u >> 16) & 1u)) >> 16; }
typedef __bf16 bf16x2_hw __attribute__((ext_vector_type(2)));
__device__ __forceinline__ unsigned pk2(float lo, float hi) { const f32x2 v = {lo, hi}; const bf16x2_hw b = __builtin_convertvector(v, bf16x2_hw); return __builtin_bit_cast(unsigned, b); }
__device__ __forceinline__ float bf2f(unsigned short h) { return __builtin_bit_cast(float, (unsigned)h << 16); }
__device__ __forceinline__ float bflo(unsigned w) { return __builtin_bit_cast(float, w << 16); }
__device__ __forceinline__ float bfhi(unsigned w) { return __builtin_bit_cast(float, w & 0xffff0000u); }
__device__ __forceinline__ float wave_sum(float v) {
#pragma unroll
    for (int o = 1; o < 64; o <<= 1) v += __shfl_xor(v, o);
    return v;
}
__device__ __forceinline__ float wave_max(float v) {
#pragma unroll
    for (int o = 1; o < 64; o <<= 1) v = fmaxf(v, __shfl_xor(v, o));
    return v;
}
__device__ __forceinline__ float silu_acc(float x) { return x / (1.0f + expf(-x)); }
__device__ __forceinline__ float silu_fast(float x) { return x * __builtin_amdgcn_rcpf(1.0f + __builtin_amdgcn_exp2f(x * -1.4426950408889634f)); }

#define XB_TMO      128
#define XB_XCNT(j)  (256  + 64 * (j))
#define XB_XSUB(j)  (1280 + 64 * (j))
#define XB_XGEN(j)  (2304 + 64 * (j))
#define XB_TOP      3328
#define XB_TOPGEN   3392
#define XCD_BAR_WORDS 3456
#define XB_SPIN_CAP (1u << 18)

__device__ __forceinline__ unsigned xb_ld(unsigned* p)              { return __hip_atomic_load(p, __ATOMIC_RELAXED, __HIP_MEMORY_SCOPE_AGENT); }
__device__ __forceinline__ unsigned xb_add(unsigned* p, unsigned v) { return __hip_atomic_fetch_add(p, v, __ATOMIC_RELAXED, __HIP_MEMORY_SCOPE_AGENT); }
__device__ __forceinline__ unsigned xb_xcc_id() { return (unsigned)__builtin_amdgcn_s_getreg((3 << 11) | 20) & 0xFu; }
#define XB_SPIN(cond, bar) do { unsigned _sp = 0; while (cond) { __builtin_amdgcn_s_sleep(1); \
    if ((++_sp & 255u) == 0u) { if (xb_ld(&(bar)[XB_TMO])) break; if (_sp > XB_SPIN_CAP) { atomicAdd(&(bar)[XB_TMO], 1u); break; } } } } while (0)

struct XcdBarrier {
    unsigned* bar; unsigned x;
    volatile LAS unsigned* st;
};

__device__ __forceinline__ XcdBarrier xcd_barrier_post(unsigned* bar, volatile LAS unsigned* st) {
    XcdBarrier b; b.bar = bar; b.x = xb_xcc_id(); b.st = st;
    if (threadIdx.x == 0) (void)xb_add(&bar[XB_XCNT(b.x)], 1u);
    return b;
}
__device__ __forceinline__ void xcd_barrier_complete(unsigned* bar, unsigned x, unsigned& nloc, unsigned& nx) {
    const unsigned G = gridDim.x * gridDim.y * gridDim.z;
    unsigned sum, cnt, mine, sp = 0u;
    for (;;) {
        sum = 0u; cnt = 0u; mine = 0u;
#pragma unroll
        for (unsigned j = 0; j < 16; ++j) { const unsigned c = xb_ld(&bar[XB_XCNT(j)]); sum += c; cnt += (c > 0u) ? 1u : 0u; mine = (j == x) ? c : mine; }
        if (sum == G) break;
        __builtin_amdgcn_s_sleep(1);
        if ((++sp & 255u) == 0u) { if (xb_ld(&bar[XB_TMO])) break; if (sp > XB_SPIN_CAP) { atomicAdd(&bar[XB_TMO], 1u); break; } }
    }
    nloc = mine > 0u ? mine : 1u; nx = cnt > 0u ? cnt : 1u;
}

__device__ __forceinline__ void xcd_barrier(const XcdBarrier& b) {
    asm volatile("s_waitcnt vmcnt(0)" ::: "memory");
    __syncthreads();
    if (threadIdx.x == 0) {
        unsigned* bar = b.bar;
        __builtin_amdgcn_s_waitcnt(0);
        unsigned nloc = b.st[0], nx = b.st[1];
        if (nloc == 0u) { xcd_barrier_complete(bar, b.x, nloc, nx); b.st[0] = nloc; b.st[1] = nx; }
        const unsigned old = xb_add(&bar[XB_XSUB(b.x)], 1u);
        const unsigned gen = old / nloc;
        if (old + 1u == (gen + 1u) * nloc) {
            __builtin_amdgcn_fence(__ATOMIC_RELEASE, "agent");
            asm volatile("s_waitcnt vmcnt(0)" ::: "memory");
            const unsigned og = xb_add(&bar[XB_TOP], 1u);
            const unsigned tg = og / nx;
            if (og + 1u == (tg + 1u) * nx) xb_add(&bar[XB_TOPGEN], 1u);
            else XB_SPIN(xb_ld(&bar[XB_TOPGEN]) == tg, bar);
            __builtin_amdgcn_fence(__ATOMIC_ACQUIRE, "agent");
            xb_add(&bar[XB_XGEN(b.x)], 1u);
            asm volatile("s_waitcnt vmcnt(0)" ::: "memory");
        } else {
            XB_SPIN(xb_ld(&bar[XB_XGEN(b.x)]) == gen, bar);
            __builtin_amdgcn_fence(__ATOMIC_ACQUIRE, "agent");
            asm volatile("s_waitcnt vmcnt(0)" ::: "memory");
        }
    }
    __syncthreads();
}

struct Args { const float* in[22]; float* out; unsigned char* ws; int ph_lo, ph_hi, li, norope; };
enum { I_X = 0, I_C, I_WADA, I_BADA, I_F1PRE, I_F1POST, I_F1G, I_F1U, I_F1D, I_MPRE, I_MPOST, I_WIN, I_CONVW, I_ALOG, I_DTB, I_GNORM, I_WOUT, I_F2PRE, I_F2POST, I_F2G, I_F2U, I_F2D };

struct TItem { const float* src; bf16* dst; int ldw, K, nvalid; };
__device__ __forceinline__ void titem_load(const TItem& t, f32x4 (&v)[16], int lane) {
    const int r4 = lane >> 4, c4 = lane & 15;
    const GAS f32x4* p = (const GAS f32x4*)(t.src + (size_t)r4 * t.ldw + 4 * c4); const size_t st = (size_t)t.ldw;
#pragma unroll
    for (int i = 0; i < 16; ++i) v[i] = p[i * st];
}
__device__ __forceinline__ void titem_store(const TItem& t, const f32x4 (&v)[16], LAS float* scr, int lane) {
    const int r4 = lane >> 4, c4 = lane & 15; const bool ok = 4 * c4 < t.nvalid;
#pragma unroll
    for (int i = 0; i < 16; ++i) { LAS float* d = scr + (4 * i + r4) * 65 + 4 * c4; const f32x4 x = ok ? v[i] : (f32x4){0.f, 0.f, 0.f, 0.f}; d[0] = x.x; d[1] = x.y; d[2] = x.z; d[3] = x.w; }
    LDS_WAIT(); asm volatile("" ::: "memory");
#pragma unroll
    for (int j = 0; j < 8; ++j) { const int q = lane + 64 * j, nn = q >> 3, c = q & 7; const LAS float* s = scr + (8 * c) * 65 + nn;
        v4u o; o.x = pk2(s[0 * 65], s[1 * 65]); o.y = pk2(s[2 * 65], s[3 * 65]); o.z = pk2(s[4 * 65], s[5 * 65]); o.w = pk2(s[6 * 65], s[7 * 65]);
        *(GAS v4u*)(t.dst + (size_t)nn * t.K + 8 * c) = o; }
    LDS_WAIT(); asm volatile("" ::: "memory");
}
constexpr int CI_GU = (DM / 64) * (DFF / 64), CI_DN = (DFF / 64) * (DM / 64), CI_INA = (DM / 64) * (4096 / 64), CI_INB = (DM / 64) * (3072 / 64), CI_INP = (DM / 64) * (256 / 64), CI_OUT = (DM / 64) * (DM / 64);
constexpr int VI_F1 = 0, VI_IN = VI_F1 + 2 * CI_GU + CI_DN, VI_OUT = VI_IN + CI_INA + CI_INB + CI_INP, VI_F2GU = VI_OUT + CI_OUT, VI_F2D = VI_F2GU + 2 * CI_GU, VI_END = VI_F2D + CI_DN;
__device__ __forceinline__ TItem titem_decode(const Args& A, int vi) {
    unsigned char* ws = A.ws; int r = vi; TItem t;
#define TI_SET(Wp, ldw_, scol_, nv_, K_, WTp, drow_, k0_) do { t.src = (Wp) + (size_t)(k0_) * (ldw_) + (scol_); t.dst = (WTp) + (size_t)(drow_) * (K_) + (k0_); t.ldw = (ldw_); t.K = (K_); t.nvalid = (nv_); return t; } while (0)
#define TR_GU(Wp, WTp, add) if (r < CI_GU) { const int kb = r / (DFF / 64), n0 = (r % (DFF / 64)) * 64; TI_SET(Wp, DFF, n0, 64, DM, WTp, 256 * (n0 >> 7) + (n0 & 127) + (add), kb * 64); } r -= CI_GU;
#define TR_DN(Wp, WTp) if (r < CI_DN) { const int kb = r / (DM / 64), n0 = (r % (DM / 64)) * 64; TI_SET(Wp, DM, n0, 64, DFF, WTp, n0, kb * 64); } r -= CI_DN;
    TR_GU(A.in[I_F1G], (bf16*)(ws + WS_WGU1), 0)
    TR_GU(A.in[I_F1U], (bf16*)(ws + WS_WGU1), 128)
    TR_DN(A.in[I_F1D], (bf16*)(ws + WS_WD1))
    bf16* WIN = (bf16*)(ws + WS_WIN);
    if (r < CI_INA) { const int kb = r / 64, n0 = (r % 64) * 64; TI_SET(A.in[I_WIN], INC, n0, 64, DM, WIN, n0, kb * 64); } r -= CI_INA;
    if (r < CI_INB) { const int kb = r / 48, n0 = (r % 48) * 64; TI_SET(A.in[I_WIN], INC, 4112 + n0, 64, DM, WIN, 4096 + n0, kb * 64); } r -= CI_INB;
    if (r < CI_INP) { const int kb = r / 4, n0 = (r % 4) * 64; TI_SET(A.in[I_WIN], INC, 4096, n0 == 0 ? 16 : 0, DM, WIN, 7168 + n0, kb * 64); } r -= CI_INP;
    if (r < CI_OUT) { const int kb = r / 32, n0 = (r % 32) * 64; TI_SET(A.in[I_WOUT], DM, n0, 64, DM, (bf16*)(ws + WS_WOUT), n0, kb * 64); } r -= CI_OUT;
    TR_GU(A.in[I_F2G], (bf16*)(ws + WS_WGU2), 0)
    TR_GU(A.in[I_F2U], (bf16*)(ws + WS_WGU2), 128)
    { const int kb = r / (DM / 64), n0 = (r % (DM / 64)) * 64; TI_SET(A.in[I_F2D], DM, n0, 64, DFF, (bf16*)(ws + WS_WD2), n0, kb * 64); }
#undef TR_GU
#undef TR_DN
#undef TI_SET
}
__device__ __forceinline__ void conv_stream(const Args& A, int first, int last, int step, LAS float* scr, int lane) {
    for (int it = first; it < last; it += step) { const TItem t = titem_decode(A, it); f32x4 v[16]; titem_load(t, v, lane); titem_store(t, v, scr, lane); }
}
__device__ __forceinline__ void adaln_wait(const Args& A, unsigned need, int tid) {
    if (tid == 0) { unsigned sp = 0; while (__hip_atomic_load((unsigned*)(A.ws + WS_CTL) + CW_ADA, __ATOMIC_RELAXED, __HIP_MEMORY_SCOPE_AGENT) < need) { __builtin_amdgcn_s_sleep(4); if (++sp > (1u << 22)) break; }
        __builtin_amdgcn_fence(__ATOMIC_ACQUIRE, "agent"); asm volatile("s_waitcnt vmcnt(0)" ::: "memory"); }
    __syncthreads();
}
__device__ __forceinline__ void adaln_ks_item(const Args& A, int item, LAS unsigned char* lds, int tid, int lane, int wave) {
    asm volatile("" : "+v"(tid), "+v"(lane));
    const float* c = A.in[I_C]; const float* w_ada = A.in[I_WADA]; float* part = (float*)(A.ws + WS_APART);
    const int cc = item >> 2, kq = item & 3;
    LAS float* sl = (LAS float*)lds;
    LAS float* red = (LAS float*)(lds + 32768);
    __syncthreads();
    for (int i = tid; i < NB * 512; i += NTHR) { const int b = i >> 9, k = i & 511; sl[k * 4 + b] = silu_acc(c[b * DM + 512 * kq + k]); }
    __syncthreads();
    f32x2 a0 = {0.f, 0.f}, a1 = a0, a2 = a0, a3 = a0;
    const GAS f32x2* wp = (const GAS f32x2*)(w_ada + (size_t)(512 * kq + wave * 64) * NMODC + cc * 128) + lane;
    const LAS f32x4* sp = (const LAS f32x4*)sl + wave * 64;
#pragma unroll 16
    for (int kk = 0; kk < 64; ++kk) { const f32x2 w = wp[(size_t)kk * (NMODC / 2)]; const f32x4 s = sp[kk]; a0 += s.x * w; a1 += s.y * w; a2 += s.z * w; a3 += s.w * w; }
    red[(wave * 4 + 0) * 128 + 2 * lane] = a0.x; red[(wave * 4 + 0) * 128 + 2 * lane + 1] = a0.y;
    red[(wave * 4 + 1) * 128 + 2 * lane] = a1.x; red[(wave * 4 + 1) * 128 + 2 * lane + 1] = a1.y;
    red[(wave * 4 + 2) * 128 + 2 * lane] = a2.x; red[(wave * 4 + 2) * 128 + 2 * lane + 1] = a2.y;
    red[(wave * 4 + 3) * 128 + 2 * lane] = a3.x; red[(wave * 4 + 3) * 128 + 2 * lane + 1] = a3.y;
    __syncthreads();
    { const int b = tid >> 7, col = tid & 127; float s = (kq == 0) ? A.in[I_BADA][cc * 128 + col] : 0.f;
#pragma unroll
      for (int w = 0; w < 8; ++w) s += red[(w * 4 + b) * 128 + col];
      part[(size_t)(kq * NB + b) * NMODC + cc * 128 + col] = s; }
    asm volatile("s_waitcnt vmcnt(0)" ::: "memory"); __syncthreads();
    LAS unsigned* flag = (LAS unsigned*)(lds + 32768 + 16384);
    if (tid == 0) { __builtin_amdgcn_fence(__ATOMIC_RELEASE, "agent"); asm volatile("s_waitcnt vmcnt(0)" ::: "memory");
        const unsigned old = __hip_atomic_fetch_add((unsigned*)(A.ws + WS_CTL) + CW_ADAC + cc, 1u, __ATOMIC_RELAXED, __HIP_MEMORY_SCOPE_AGENT);
        if (old == 3u) { __builtin_amdgcn_fence(__ATOMIC_ACQUIRE, "agent"); asm volatile("s_waitcnt vmcnt(0)" ::: "memory"); }
        flag[0] = (old == 3u) ? 1u : 0u; }
    __syncthreads();
    if (flag[0] != 0u) { const int b = tid >> 7, col = tid & 127; const size_t o = (size_t)b * NMODC + cc * 128 + col;
        const float s = (part[o] + part[o + (size_t)NB * NMODC]) + (part[o + (size_t)2 * NB * NMODC] + part[o + (size_t)3 * NB * NMODC]);
        ((float*)(A.ws + WS_MOD))[o] = s;
        asm volatile("s_waitcnt vmcnt(0)" ::: "memory"); __syncthreads();
        if (tid == 0) { __builtin_amdgcn_fence(__ATOMIC_RELEASE, "agent"); asm volatile("s_waitcnt vmcnt(0)" ::: "memory"); __hip_atomic_fetch_add((unsigned*)(A.ws + WS_CTL) + CW_ADA, 1u, __ATOMIC_RELAXED, __HIP_MEMORY_SCOPE_AGENT); } }
    __syncthreads();
}
__device__ __forceinline__ void fill_slot(const Args& A, LAS unsigned char* lds, int tid, int lane, int wave, int sb, int nb, int a0, int nada, int vlo, int vhi, int c1) {
    for (int it = a0 + sb; it < a0 + nada; it += nb) adaln_ks_item(A, it, lds, tid, lane, wave);
    __syncthreads();
    LAS float* scr = (LAS float*)(lds + wave * 16640);
    const int nh = nada % nb; const int sw = sb * NWAVES + wave, nwa = nb * NWAVES, nwl = nh * NWAVES;
    conv_stream(A, vlo + sw, vlo + c1, nwa, scr, lane);
    if (sb >= nh) conv_stream(A, vlo + c1 + (sw - nwl), vhi, nwa - nwl, scr, lane);
}
__device__ __forceinline__ void rope_table(const Args& A, int tid) {
    const int e = (int)blockIdx.x * NTHR + tid;
    if (e < SEQ * 16) { const int pos = e >> 4, i = e & 15;
        const float invf = (float)exp2(-(double)i * (18.931568569324174 / 16.0));
        const float ang = (float)pos * invf; const double ad = (double)ang;
        const double q = rint(ad * 0.63661977236758134308); const double r = ad - q * 1.57079632679489661923; const double r2 = r * r;
        const double sr = r * (1.0 + r2 * (-1.0 / 6 + r2 * (1.0 / 120 + r2 * (-1.0 / 5040 + r2 * (1.0 / 362880 + r2 * (-1.0 / 39916800 + r2 * (1.0 / 6227020800.0)))))));
        const double cr = 1.0 + r2 * (-0.5 + r2 * (1.0 / 24 + r2 * (-1.0 / 720 + r2 * (1.0 / 40320 + r2 * (-1.0 / 3628800 + r2 * (1.0 / 479001600.0))))));
        const int qi = ((int)q) & 3; double sv, cv;
        if (qi == 0) { sv = sr; cv = cr; } else if (qi == 1) { sv = cr; cv = -sr; } else if (qi == 2) { sv = -sr; cv = -cr; } else { sv = -cr; cv = sr; }
        ((f32x2*)(A.ws + WS_ROPE))[e] = (f32x2){(float)cv, (float)sv}; }
}

template <int MODE>
__device__ __forceinline__ void row_pass(const float* xr, const float* Y, float* xo, bf16* H, const float* mod, const float* post_g, int i_ga, float gscale, const float* pre_g, int i_sh, int i_sc, int gw, int NGW, int lane) {
    for (int row = gw; row < M; row += NGW) {
        const int b = row >> 11;
        const GAS f32x4* xp = (const GAS f32x4*)(xr + (size_t)row * DM) + lane;
        f32x4 x[8];
#pragma unroll
        for (int j = 0; j < 8; ++j) x[j] = xp[64 * j];
        if (MODE != 0) {
            const GAS f32x4* yp = (const GAS f32x4*)(Y + (size_t)row * DM) + lane;
            f32x4 y[8]; float ss = 0.f;
#pragma unroll
            for (int j = 0; j < 8; ++j) { y[j] = yp[64 * j]; ss += (y[j].x * y[j].x + y[j].y * y[j].y) + (y[j].z * y[j].z + y[j].w * y[j].w); }
            const float rstd = 1.0f / sqrtf(wave_sum(ss) * (1.0f / DM) + EPS);
            const GAS f32x4* gp = (const GAS f32x4*)post_g + lane; const GAS f32x4* gap = (const GAS f32x4*)(mod + (size_t)b * NMODC + i_ga * DM) + lane;
            GAS f32x4* op = (GAS f32x4*)(xo + (size_t)row * DM) + lane;
#pragma unroll
            for (int j = 0; j < 8; ++j) { const f32x4 g = gp[64 * j], ga = gap[64 * j]; x[j] = x[j] + (gscale * ga) * ((y[j] * rstd) * g); op[64 * j] = x[j]; }
        }
        if (MODE != 2) {
            float ss = 0.f;
#pragma unroll
            for (int j = 0; j < 8; ++j) ss += (x[j].x * x[j].x + x[j].y * x[j].y) + (x[j].z * x[j].z + x[j].w * x[j].w);
            const float rstd = 1.0f / sqrtf(wave_sum(ss) * (1.0f / DM) + EPS);
            const GAS f32x4* gp = (const GAS f32x4*)pre_g + lane; const GAS f32x4* scp = (const GAS f32x4*)(mod + (size_t)b * (MODE == 0 ? 4096 : NMODC) + i_sc * DM) + lane; const GAS f32x4* shp = (const GAS f32x4*)(mod + (size_t)b * (MODE == 0 ? 4096 : NMODC) + i_sh * DM) + lane;
            GAS v2u* hp = (GAS v2u*)(H + (size_t)row * DM) + lane;
#pragma unroll
            for (int j = 0; j < 8; ++j) { const f32x4 g = gp[64 * j]; f32x4 sc = scp[64 * j], sh = shp[64 * j];
                if (MODE == 0) { sc = (sc + scp[64 * j + NB * 1024]) + (scp[64 * j + 2 * NB * 1024] + scp[64 * j + 3 * NB * 1024]); sh = (sh + shp[64 * j + NB * 1024]) + (shp[64 * j + 2 * NB * 1024] + shp[64 * j + 3 * NB * 1024]); }
                const f32x4 h = ((x[j] * rstd) * g) * (1.0f + sc) + sh;
                v2u o; o.x = pk2(h.x, h.y); o.y = pk2(h.z, h.w); hp[64 * j] = o; }
        }
    }
}

__device__ __forceinline__ void row_pass_first(const Args& A, LAS unsigned char* lds, bf16* H, int gw, int NGW, int tid, int lane) {
    const float* modp = (const float*)(A.ws + WS_MOD); const float* xr = A.in[I_X]; const float* pre_g = A.in[I_F1PRE];
    LAS f32x4* Am = (LAS f32x4*)lds; LAS f32x4* Bm = (LAS f32x4*)(lds + 32768);
#pragma unroll
    for (int i = 0; i < 4; ++i) { const int p = tid + NTHR * i, b = p >> 9, c4 = p & 511;
        const GAS f32x4* ps = (const GAS f32x4*)(modp + (size_t)b * NMODC) + c4; const f32x4 sh = ps[0], sc = ps[512];
        const f32x4 g = ((const GAS f32x4*)pre_g)[c4]; Am[p] = g * (1.0f + sc); Bm[p] = sh; }
    __syncthreads();
    if (M == 4 * NGW) {
        f32x4 x[4][8];
#pragma unroll
        for (int i = 0; i < 4; ++i) { const GAS f32x4* xp = (const GAS f32x4*)(xr + (size_t)(gw + i * NGW) * DM) + lane;
#pragma unroll
            for (int j = 0; j < 8; ++j) x[i][j] = xp[64 * j]; }
#pragma unroll
        for (int i = 0; i < 4; ++i) { const int row = gw + i * NGW, b = row >> 11; float ss = 0.f;
#pragma unroll
            for (int j = 0; j < 8; ++j) ss += (x[i][j].x * x[i][j].x + x[i][j].y * x[i][j].y) + (x[i][j].z * x[i][j].z + x[i][j].w * x[i][j].w);
            const float rstd = 1.0f / sqrtf(wave_sum(ss) * (1.0f / DM) + EPS);
            GAS v2u* hp = (GAS v2u*)(H + (size_t)row * DM) + lane;
#pragma unroll
            for (int j = 0; j < 8; ++j) { const f32x4 h = (x[i][j] * rstd) * Am[b * 512 + lane + 64 * j] + Bm[b * 512 + lane + 64 * j]; v2u o; o.x = pk2(h.x, h.y); o.y = pk2(h.z, h.w); hp[64 * j] = o; } }
    } else {
        for (int row = gw; row < M; row += NGW) { const int b = row >> 11; const GAS f32x4* xp = (const GAS f32x4*)(xr + (size_t)row * DM) + lane; f32x4 x[8]; float ss = 0.f;
#pragma unroll
            for (int j = 0; j < 8; ++j) { x[j] = xp[64 * j]; ss += (x[j].x * x[j].x + x[j].y * x[j].y) + (x[j].z * x[j].z + x[j].w * x[j].w); }
            const float rstd = 1.0f / sqrtf(wave_sum(ss) * (1.0f / DM) + EPS); GAS v2u* hp = (GAS v2u*)(H + (size_t)row * DM) + lane;
#pragma unroll
            for (int j = 0; j < 8; ++j) { const f32x4 h = (x[j] * rstd) * Am[b * 512 + lane + 64 * j] + Bm[b * 512 + lane + 64 * j]; v2u o; o.x = pk2(h.x, h.y); o.y = pk2(h.z, h.w); hp[64 * j] = o; } }
    }
}
__device__ __forceinline__ void rope_q_phase(const Args& A, int gw, int NGW, int lane) {
    unsigned char* ws = A.ws; bf16* PROJ = (bf16*)(ws + WS_PROJ); const f32x2* rope = (const f32x2*)(ws + WS_ROPE);
    for (int row = gw; row < M; row += NGW) {
        const int s = row & (SEQ - 1);
#pragma unroll
        for (int jj = 0; jj < 2; ++jj) { const int p = lane + 64 * jj, hh = (p >> 4) & 7, i = p & 15;
            bf16* c1 = PROJ + (size_t)row * NIN + PC_MQ + hh * 128 + i; const float x1 = bf2f(c1[0]), x2 = bf2f(c1[16]); const f32x2 cs = rope[s * 16 + i];
            c1[0] = (bf16)f2bf(x1 * cs.x - x2 * cs.y); c1[16] = (bf16)f2bf(x2 * cs.x + x1 * cs.y); }
    }
}
__device__ __forceinline__ void krope_kmean_item(const Args& A, int it, LAS unsigned char* lds, int tid) {
    bf16* PROJ = (bf16*)(A.ws + WS_PROJ); float* KM = (float*)(A.ws + WS_KMEAN); const f32x2* rope = (const f32x2*)(A.ws + WS_ROPE); LAS float* red = (LAS float*)lds;
    const int b = it >> 6, n = (it >> 3) & 7, h = it & 7; const int rg = tid >> 4, c8 = tid & 15;
    float sum[8];
#pragma unroll
    for (int e = 0; e < 8; ++e) sum[e] = 0.f;
    __syncthreads();
#pragma unroll
    for (int rr = 0; rr < 8; ++rr) { const int s = n * 256 + rg * 8 + rr; bf16* p = PROJ + (size_t)(b * SEQ + s) * NIN + PC_MK + h * 128 + 8 * c8;
        v4u v = *(const GAS v4u*)p; float f[8] = {bflo(v.x), bfhi(v.x), bflo(v.y), bfhi(v.y), bflo(v.z), bfhi(v.z), bflo(v.w), bfhi(v.w)};
        const unsigned px = __shfl_xor(v.x, 2), py = __shfl_xor(v.y, 2), pz = __shfl_xor(v.z, 2), pw = __shfl_xor(v.w, 2);
        if (c8 < 4) { const float g[8] = {bflo(px), bfhi(px), bflo(py), bfhi(py), bflo(pz), bfhi(pz), bflo(pw), bfhi(pw)};
#pragma unroll
            for (int e = 0; e < 8; ++e) { const f32x2 cs = rope[s * 16 + (c8 & 1) * 8 + e]; f[e] = (c8 < 2) ? f[e] * cs.x - g[e] * cs.y : f[e] * cs.x + g[e] * cs.y; }
            v.x = pk2(f[0], f[1]); v.y = pk2(f[2], f[3]); v.z = pk2(f[4], f[5]); v.w = pk2(f[6], f[7]); *(GAS v4u*)p = v;
            f[0] = bflo(v.x); f[1] = bfhi(v.x); f[2] = bflo(v.y); f[3] = bfhi(v.y); f[4] = bflo(v.z); f[5] = bfhi(v.z); f[6] = bflo(v.w); f[7] = bfhi(v.w); }
#pragma unroll
        for (int e = 0; e < 8; ++e) sum[e] += f[e]; }
#pragma unroll
    for (int e = 0; e < 8; ++e) red[rg * 128 + 8 * c8 + e] = sum[e];
    __syncthreads();
    if (tid < 128) { float s = 0.f;
#pragma unroll
        for (int g = 0; g < 32; ++g) s += red[g * 128 + tid];
        KM[((b * 8 + h) * 8 + n) * 128 + tid] = s * (1.0f / 256.0f); }
}
namespace gdn {
typedef float f32x16 __attribute__((ext_vector_type(16)));
constexpr int OPS_BYTES = 57344, WF_OFF = 0, QGF_OFF = 16384, KDF_OFF = 32768, AF_OFF = 49152;
constexpr int UF_BYTES = 32768, GZ_BYTES = 16384;
constexpr int IMG_ST = 136;
constexpr int L_KS = 0, L_VS = 32768, L_X = 65536, L_KHI = L_X, L_KLO = L_X + 17408, L_QHI = L_X + 34816, L_LM = L_X, L_AM = L_X + 16384, L_WB = L_QHI, L_SM = L_X + 52224;
__device__ __forceinline__ int crow(int r, int hi) { return (r & 3) + 8 * (r >> 2) + 4 * hi; }
__device__ __forceinline__ unsigned pkbf(float lo, float hi) { return pk2(lo, hi); }

#define LDS_BAR() do { asm volatile("s_waitcnt lgkmcnt(0)" ::: "memory"); __builtin_amdgcn_s_barrier(); asm volatile("" ::: "memory"); } while (0)
constexpr int C32_UP = (DM / 64) * (DFF / 32), C32_OUT = (DM / 64) * (DM / 32), C32_ALL = C32_UP + C32_OUT, L_C32 = 118784;
__device__ __forceinline__ void conv32_item(const Args& A, int j, LAS float* scr, int lane) {
    const float* src; bf16* dst; int ldw;
    if (j < C32_UP) { const int kb = j / (DFF / 32), n0 = (j % (DFF / 32)) * 32; src = A.in[I_F2U] + (size_t)(kb * 64) * DFF + n0; dst = (bf16*)(A.ws + WS_WGU2) + (size_t)(256 * (n0 >> 7) + (n0 & 127) + 128) * DM + kb * 64; ldw = DFF; }
    else { const int jj = j - C32_UP, kb = jj / (DM / 32), n0 = (jj % (DM / 32)) * 32; src = A.in[I_WOUT] + (size_t)(kb * 64) * DM + n0; dst = (bf16*)(A.ws + WS_WOUT) + (size_t)n0 * DM + kb * 64; ldw = DM; }
    const int r8 = lane >> 3, c4 = lane & 7; const GAS f32x4* p = (const GAS f32x4*)(src + (size_t)r8 * ldw + 4 * c4); f32x4 v[8];
#pragma unroll
    for (int i = 0; i < 8; ++i) v[i] = p[(size_t)i * 2 * ldw];
#pragma unroll
    for (int i = 0; i < 8; ++i) { LAS float* d = scr + (8 * i + r8) * 33 + 4 * c4; d[0] = v[i].x; d[1] = v[i].y; d[2] = v[i].z; d[3] = v[i].w; }
    LDS_WAIT(); asm volatile("" ::: "memory");
#pragma unroll
    for (int jq = 0; jq < 4; ++jq) { const int q = lane + 64 * jq, nn = q >> 3, c = q & 7; const LAS float* s = scr + (8 * c) * 33 + nn;
        v4u o; o.x = pk2(s[0 * 33], s[1 * 33]); o.y = pk2(s[2 * 33], s[3 * 33]); o.z = pk2(s[4 * 33], s[5 * 33]); o.w = pk2(s[6 * 33], s[7 * 33]);
        *(GAS v4u*)(dst + (size_t)nn * DM + 8 * c) = o; }
    LDS_WAIT(); asm volatile("" ::: "memory");
}

__device__ __forceinline__ void prep_touch(const Args& A, int item, int th) {
    const int b = item >> 8, h = (item >> 5) & 7, n = item & 31; const int t0 = b * SEQ + n * 64, s0 = n * 64; const bf16* PROJ = (const bf16*)(A.ws + WS_PROJ);
    unsigned sink = 0u;
#pragma unroll
    for (int i = 0; i < 2; ++i) { const int idx = th + 256 * i, row = idx / 6, l6 = idx % 6;
        if (row < 67 && s0 + row - 3 >= 0) sink ^= *(const GAS unsigned*)(PROJ + (size_t)(t0 + row - 3) * NIN + (l6 >> 1) * 1024 + h * 128 + (l6 & 1) * 64); }
    if (th < 128) sink ^= *(const GAS unsigned*)(PROJ + (size_t)(t0 + (th >> 1)) * NIN + PC_GZ + h * 128 + (th & 1) * 64);
    else if (th < 192) sink ^= *(const GAS unsigned*)(PROJ + (size_t)(t0 + th - 128) * NIN + PC_A);
    asm volatile("" :: "v"(sink));
}
__device__ __forceinline__ void prep_item(const Args& A, int item, LAS unsigned char* lds, int tid, int lane, int wave) {
    asm volatile("" : "+v"(tid), "+v"(lane));
    const int b = item >> 8, h = (item >> 5) & 7, n = item & 31; const int t0 = b * SEQ + n * 64, s0 = n * 64;
    unsigned char* ws = A.ws; const bf16* PROJ = (const bf16*)(ws + WS_PROJ);
    unsigned char* ops = ws + WS_OPS + (size_t)item * OPS_BYTES; float* UF = (float*)(ws + WS_UF + (size_t)item * UF_BYTES); bf16* GZ = (bf16*)(ws + WS_GZ + (size_t)item * GZ_BYTES);
    LAS float* ks = (LAS float*)(lds + L_KS); LAS float* vs = (LAS float*)(lds + L_VS);
    LAS bf16* khi = (LAS bf16*)(lds + L_KHI); LAS bf16* klo = (LAS bf16*)(lds + L_KLO); LAS bf16* qhi = (LAS bf16*)(lds + L_QHI);
    LAS float* Lm = (LAS float*)(lds + L_LM); LAS float* Am = (LAS float*)(lds + L_AM); LAS bf16* Wb = (LAS bf16*)(lds + L_WB);
    LAS float* Gs = (LAS float*)(lds + L_SM); LAS float* bs = Gs + 64; LAS float* es = Gs + 128; LAS float* dsx = Gs + 192;
    LDS_BAR();
    if (wave == 6) {
        const float av = bf2f(PROJ[(size_t)(t0 + lane) * NIN + PC_A + h]), bv = bf2f(PROJ[(size_t)(t0 + lane) * NIN + PC_B + h]);
        const float xx = av + A.in[I_DTB][h]; const float sp = fmaxf(xx, 0.f) + log1pf(expf(-fabsf(xx)));
        float G = -expf(A.in[I_ALOG][h]) * sp;
#pragma unroll
        for (int o = 1; o < 64; o <<= 1) { const float t = __shfl_up(G, o); if (lane >= o) G += t; }
        const float Gl = __shfl(G, 63);
        Gs[lane] = G; bs[lane] = 1.0f / (1.0f + expf(-bv)); es[lane] = expf(G); dsx[lane] = expf(Gl - G);
        if (lane == 0) ((float*)(ws + WS_DEC))[item] = expf(Gl);
    }
    v4u zpre[4] = {};
    if (wave >= 4) {
#pragma unroll
        for (int it = 0; it < 4; ++it) { const int e = (tid - 256) + 256 * it; zpre[it] = *(const GAS v4u*)(PROJ + (size_t)(t0 + (e >> 4)) * NIN + PC_GZ + h * 128 + 8 * (e & 15)); } }
    const int r = tid >> 3, cg = tid & 7;
    const int mat = wave >> 1, cgn = tid & 7, rg4 = (tid & 127) >> 3;
    float qv[4][16];
    if (wave < 6) {
        const int col = mat * 1024 + h * 128 + 16 * cgn;
        f32x4 wt[4][4];
#pragma unroll
        for (int jj = 0; jj < 4; ++jj) { const GAS f32x4* wp = (const GAS f32x4*)(A.in[I_CONVW] + jj * CONVC + col); wt[jj][0] = wp[0]; wt[jj][1] = wp[1]; wt[jj][2] = wp[2]; wt[jj][3] = wp[3]; }
        v4u in0[7], in1[7];
#pragma unroll
        for (int k = 0; k < 7; ++k) { const int row = 4 * rg4 - 3 + k; const bool okr = (s0 + row) >= 0;
            const GAS v4u* pp = (const GAS v4u*)(PROJ + (size_t)(okr ? t0 + row : t0) * NIN + col); const v4u a0 = pp[0], a1 = pp[1];
            in0[k] = okr ? a0 : (v4u){0u, 0u, 0u, 0u}; in1[k] = okr ? a1 : (v4u){0u, 0u, 0u, 0u}; }
#pragma unroll
        for (int rr = 0; rr < 4; ++rr) { const int row = 4 * rg4 + rr; float acc[16];
#pragma unroll
            for (int i = 0; i < 16; ++i) acc[i] = 0.f;
#pragma unroll
            for (int jj = 0; jj < 4; ++jj) { const v4u v0 = in0[rr + jj], v1 = in1[rr + jj]; const f32x4 w0 = wt[jj][0], w1 = wt[jj][1], w2 = wt[jj][2], w3 = wt[jj][3];
                acc[0] += w0.x * bflo(v0.x); acc[1] += w0.y * bfhi(v0.x); acc[2] += w0.z * bflo(v0.y); acc[3] += w0.w * bfhi(v0.y);
                acc[4] += w1.x * bflo(v0.z); acc[5] += w1.y * bfhi(v0.z); acc[6] += w1.z * bflo(v0.w); acc[7] += w1.w * bfhi(v0.w);
                acc[8] += w2.x * bflo(v1.x); acc[9] += w2.y * bfhi(v1.x); acc[10] += w2.z * bflo(v1.y); acc[11] += w2.w * bfhi(v1.y);
                acc[12] += w3.x * bflo(v1.z); acc[13] += w3.y * bfhi(v1.z); acc[14] += w3.z * bflo(v1.w); acc[15] += w3.w * bfhi(v1.w); }
            float ss = 0.f;
#pragma unroll
            for (int i = 0; i < 16; ++i) { acc[i] = silu_fast(acc[i]); ss += acc[i] * acc[i]; }
            if (mat < 2) { ss += __shfl_xor(ss, 1); ss += __shfl_xor(ss, 2); ss += __shfl_xor(ss, 4); const float rn = (1.0f / sqrtf(ss + EPS)) * (mat == 0 ? 0.08838834764831845f : 1.0f);
#pragma unroll
                for (int i = 0; i < 16; ++i) acc[i] *= rn; }
            if (mat == 0) {
#pragma unroll
                for (int i = 0; i < 16; ++i) qv[rr][i] = acc[i];
                unsigned w[8];
#pragma unroll
                for (int i = 0; i < 8; ++i) w[i] = pkbf(acc[2 * i], acc[2 * i + 1]);
                LAS v4u* dst = (LAS v4u*)(qhi + row * IMG_ST + 16 * cgn); dst[0] = (v4u){w[0], w[1], w[2], w[3]}; dst[1] = (v4u){w[4], w[5], w[6], w[7]};
            } else if (mat == 1) {
                LAS f32x4* kd = (LAS f32x4*)(ks + row * 128 + 16 * cgn);
#pragma unroll
                for (int i = 0; i < 4; ++i) kd[i] = (f32x4){acc[4 * i], acc[4 * i + 1], acc[4 * i + 2], acc[4 * i + 3]};
                unsigned wh[8], wl[8];
#pragma unroll
                for (int i = 0; i < 8; ++i) { const unsigned h0 = f2bf(acc[2 * i]), h1 = f2bf(acc[2 * i + 1]); wh[i] = h0 | (h1 << 16);
                    wl[i] = pkbf(acc[2 * i] - __builtin_bit_cast(float, h0 << 16), acc[2 * i + 1] - __builtin_bit_cast(float, h1 << 16)); }
                LAS v4u* dh = (LAS v4u*)(khi + row * IMG_ST + 16 * cgn); dh[0] = (v4u){wh[0], wh[1], wh[2], wh[3]}; dh[1] = (v4u){wh[4], wh[5], wh[6], wh[7]};
                LAS v4u* dl = (LAS v4u*)(klo + row * IMG_ST + 16 * cgn); dl[0] = (v4u){wl[0], wl[1], wl[2], wl[3]}; dl[1] = (v4u){wl[4], wl[5], wl[6], wl[7]};
            } else {
                LAS f32x4* vd = (LAS f32x4*)(vs + row * 128 + 16 * cgn);
#pragma unroll
                for (int i = 0; i < 4; ++i) vd[i] = (f32x4){acc[4 * i], acc[4 * i + 1], acc[4 * i + 2], acc[4 * i + 3]};
            }
        }
    }
    LDS_BAR();
    if (wave < 2) {
#pragma unroll
        for (int rr = 0; rr < 4; ++rr) { const int row = 4 * rg4 + rr; const float e = es[row]; unsigned w[8];
#pragma unroll
            for (int i = 0; i < 8; ++i) w[i] = pkbf(qv[rr][2 * i] * e, qv[rr][2 * i + 1] * e);
            unsigned char* dst = ops + QGF_OFF + ((((row >> 5) * 4 + (cgn >> 1)) * 2 + (cgn & 1)) * 64 + (row & 31)) * 16;
            *(GAS v4u*)dst = (v4u){w[0], w[1], w[4], w[5]}; *(GAS v4u*)(dst + 512) = (v4u){w[2], w[3], w[6], w[7]}; } }
    f32x16 acc = {};
    const int job = wave % 3, mt = job == 0 ? 0 : 1, nt = job == 2 ? 1 : 0; const int r32 = lane & 31, hh = lane >> 5; const bool kkj = wave < 3;
    if (wave < 6) {
        const LAS bf16* Aimg = (wave < 3) ? khi : qhi;
#pragma unroll
        for (int ksx = 0; ksx < 8; ++ksx) {
            const bf16x8 a = *(const LAS bf16x8*)(Aimg + (32 * mt + r32) * IMG_ST + 16 * ksx + 8 * hh);
            const bf16x8 bh = *(const LAS bf16x8*)(khi + (32 * nt + r32) * IMG_ST + 16 * ksx + 8 * hh);
            acc = __builtin_amdgcn_mfma_f32_32x32x16_bf16(a, bh, acc, 0, 0, 0);
            if (wave < 3) {
                const bf16x8 al = *(const LAS bf16x8*)(klo + (32 * mt + r32) * IMG_ST + 16 * ksx + 8 * hh);
                const bf16x8 bl = *(const LAS bf16x8*)(klo + (32 * nt + r32) * IMG_ST + 16 * ksx + 8 * hh);
                acc = __builtin_amdgcn_mfma_f32_32x32x16_bf16(a, bl, acc, 0, 0, 0);
                acc = __builtin_amdgcn_mfma_f32_32x32x16_bf16(al, bh, acc, 0, 0, 0);
            }
        }
    }
    LDS_BAR();
    if (wave < 6) { const int j = 32 * nt + r32; const float Gj = Gs[j];
#pragma unroll
        for (int rg = 0; rg < 16; ++rg) { const int i = 32 * mt + crow(rg, hh); const float d = __builtin_amdgcn_exp2f((Gs[i] - Gj) * 1.4426950408889634f);
            if (kkj) Lm[i * 64 + j] = (j < i) ? bs[i] * acc[rg] * d : 0.f;
            else Am[i * 64 + j] = (j <= i) ? acc[rg] * d : 0.f; } }
    LDS_BAR();
    if (wave < 4) {
        float x[64]; const int c2 = tid; int lz; asm volatile("v_mov_b32 %0, 0" : "=v"(lz));
#pragma unroll
        for (int i = 0; i < 64; ++i) x[i] = bs[i + lz] * ((c2 < 128) ? vs[i * 128 + c2] : ks[i * 128 + (c2 - 128)] * es[i + lz]);
        f32x4 lc[16], ln[16];
#pragma unroll
        for (int j4 = 0; j4 < 16; ++j4) { lc[j4] = (f32x4){0.f, 0.f, 0.f, 0.f}; ln[j4] = lc[j4]; }
        lc[0] = *(const LAS f32x4*)(Lm + 64 + lz);
#pragma unroll
        for (int i = 1; i < 64; ++i) {
            if (i + 1 < 64) {
#pragma unroll
                for (int j4 = 0; j4 < (i + 4) / 4; ++j4) ln[j4] = *(const LAS f32x4*)(Lm + (i + 1) * 64 + 4 * j4 + lz); }
            __builtin_amdgcn_sched_barrier(0);
            f32x2 a0 = {0.f, 0.f}, a1 = {0.f, 0.f};
#pragma unroll
            for (int j4 = 0; j4 < (i + 3) / 4; ++j4) { const f32x4 l = lc[j4];
                a0 += (f32x2){l.x, l.y} * (f32x2){x[4 * j4], x[4 * j4 + 1]}; a1 += (f32x2){l.z, l.w} * (f32x2){x[4 * j4 + 2], x[4 * j4 + 3]}; }
            x[i] -= (a0.x + a0.y) + (a1.x + a1.y);
            __builtin_amdgcn_sched_barrier(0);
#pragma unroll
            for (int j4 = 0; j4 < 16; ++j4) lc[j4] = ln[j4];
        }
        if (c2 < 128) { const int w = c2 >> 5, c = c2 & 31;
#pragma unroll
            for (int m2 = 0; m2 < 2; ++m2)
#pragma unroll
                for (int rq = 0; rq < 4; ++rq)
#pragma unroll
                    for (int hi = 0; hi < 2; ++hi) { const int tb = 32 * m2 + 8 * rq + 4 * hi;
                        *(GAS f32x4*)(UF + ((((w * 2 + m2) * 4 + rq) * 64 + c + 32 * hi) * 4)) = (f32x4){x[tb], x[tb + 1], x[tb + 2], x[tb + 3]}; }
        } else { const int dk = c2 - 128;
#pragma unroll
            for (int i = 0; i < 64; ++i) Wb[i * 128 + dk] = (bf16)f2bf(-x[i]); }
    } else {
        const int ht = tid - 256;
#pragma unroll
        for (int it = 0; it < 2; ++it) { const int e = ht + 256 * it, c = e & 127, tg = e >> 7; float kv[16];
#pragma unroll
            for (int xk = 0; xk < 16; ++xk) kv[xk] = ks[(16 * tg + xk) * 128 + c] * dsx[16 * tg + xk];
            unsigned char* dst = ops + KDF_OFF + ((((c >> 5) * 2 + (tg >> 1)) * 2 + (tg & 1)) * 64 + (c & 31)) * 16;
            *(GAS v4u*)dst = (v4u){pkbf(kv[0], kv[1]), pkbf(kv[2], kv[3]), pkbf(kv[8], kv[9]), pkbf(kv[10], kv[11])};
            *(GAS v4u*)(dst + 512) = (v4u){pkbf(kv[4], kv[5]), pkbf(kv[6], kv[7]), pkbf(kv[12], kv[13]), pkbf(kv[14], kv[15])}; }
#pragma unroll
        for (int it = 0; it < 2; ++it) { const int e = ht + 256 * it, ln = e & 63, f = e >> 6, s = f & 1, kb = (f >> 1) & 1, m2 = f >> 2; v4u o = {0u, 0u, 0u, 0u};
            if (!(m2 == 0 && kb == 1)) { const LAS float* ap = Am + (32 * m2 + (ln & 31)) * 64 + 32 * kb + 16 * s + 4 * (ln >> 5); const f32x4 a0 = *(const LAS f32x4*)ap, a1 = *(const LAS f32x4*)(ap + 8);
                o = (v4u){pkbf(a0.x, a0.y), pkbf(a0.z, a0.w), pkbf(a1.x, a1.y), pkbf(a1.z, a1.w)}; }
            *(GAS v4u*)(ops + AF_OFF + e * 16) = o; }
#pragma unroll
        for (int it = 0; it < 4; ++it) { const int e = ht + 256 * it, tok = e >> 4, c8 = e & 15;
            const v4u z = zpre[it]; const f32x4 g0 = *(const GAS f32x4*)(A.in[I_GNORM] + 8 * c8), g1 = *(const GAS f32x4*)(A.in[I_GNORM] + 8 * c8 + 4);
            v4u o; o.x = pkbf(silu_fast(bflo(z.x)) * g0.x, silu_fast(bfhi(z.x)) * g0.y); o.y = pkbf(silu_fast(bflo(z.y)) * g0.z, silu_fast(bfhi(z.y)) * g0.w);
            o.z = pkbf(silu_fast(bflo(z.z)) * g1.x, silu_fast(bfhi(z.z)) * g1.y); o.w = pkbf(silu_fast(bflo(z.w)) * g1.z, silu_fast(bfhi(z.w)) * g1.w);
            *(GAS v4u*)(GZ + tok * 128 + 8 * c8) = o; }
        if (item + (int)gridDim.x < NB * GDH * 32) prep_touch(A, item + (int)gridDim.x, ht);
    }
    LDS_BAR();
    { const LAS v4u* src = (const LAS v4u*)(Wb + r * 128 + 16 * cg); const v4u a = src[0], c = src[1];
      unsigned char* dst = ops + WF_OFF + ((((r >> 5) * 4 + (cg >> 1)) * 2 + (cg & 1)) * 64 + (r & 31)) * 16;
      *(GAS v4u*)dst = (v4u){a.x, a.y, c.x, c.y}; *(GAS v4u*)(dst + 512) = (v4u){a.z, a.w, c.z, c.w}; }
}

constexpr int SC_BUF0 = 0, SC_BUF1 = OPS_BYTES, SC_OB = 2 * OPS_BYTES, OB_ST = 132;
__device__ __forceinline__ void scan_unit(const Args& A, int bh, LAS unsigned char* lds, int tid, int lane, int wave) {
    unsigned char* ws = A.ws; const int b = bh >> 3, h = bh & 7;
    const unsigned char* ops0 = ws + WS_OPS + (size_t)(bh * 32) * OPS_BYTES; const float* UF0 = (const float*)(ws + WS_UF + (size_t)(bh * 32) * UF_BYTES);
    const bf16* GZ0 = (const bf16*)(ws + WS_GZ + (size_t)(bh * 32) * GZ_BYTES); const float* DEC = (const float*)(ws + WS_DEC) + bh * 32; bf16* YMIX = (bf16*)(ws + WS_YMIX);
    LAS float* Ob = (LAS float*)(lds + SC_OB);
    const bool helper = wave >= 4; const int hw = wave - 4, ht = tid - 256;
#define GDN_DMA(n_) do { const unsigned char* src_ = ops0 + (size_t)(n_) * OPS_BYTES; const int bo_ = ((n_) & 1) ? SC_BUF1 : SC_BUF0; \
        _Pragma("unroll") for (int p_ = 0; p_ < 14; ++p_) __builtin_amdgcn_global_load_lds((const unsigned*)(src_ + (hw * 14 + p_) * 1024 + lane * 16), (LAS unsigned*)(lds + bo_ + (hw * 14 + p_) * 1024), 16, 0, 0); } while (0)
    __syncthreads();
    if (helper) { GDN_DMA(0); asm volatile("s_waitcnt vmcnt(0)" ::: "memory"); }
    __builtin_amdgcn_s_barrier(); asm volatile("" ::: "memory");
    if (helper) {
        const int tok = ht >> 2, part = ht & 3;
        GDN_DMA(1);
        const GAS v4u* gzp0 = (const GAS v4u*)(GZ0 + tok * 128 + 32 * part); v4u z0 = gzp0[0], z1 = gzp0[1], z2 = gzp0[2], z3 = gzp0[3];
        for (int n = 0; n < 32; ++n) {
            asm volatile("" ::: "memory"); __builtin_amdgcn_s_barrier(); asm volatile("" ::: "memory");
            asm volatile("s_waitcnt vmcnt(0)" ::: "memory"); asm volatile("" : "+v"(z0), "+v"(z1), "+v"(z2), "+v"(z3));
            __builtin_amdgcn_s_barrier(); asm volatile("" ::: "memory");
            if (n + 2 < 32) GDN_DMA(n + 2);
            f32x4 o[8]; float ss = 0.f;
#pragma unroll
            for (int i = 0; i < 8; ++i) { o[i] = *(const LAS f32x4*)(Ob + tok * OB_ST + 32 * part + 4 * i); ss += (o[i].x * o[i].x + o[i].y * o[i].y) + (o[i].z * o[i].z + o[i].w * o[i].w); }
            ss += __shfl_xor(ss, 1); ss += __shfl_xor(ss, 2);
            const float rstd = 1.0f / sqrtf(ss * (1.0f / 128.0f) + EPS);
            const unsigned zz[16] = {z0.x, z0.y, z0.z, z0.w, z1.x, z1.y, z1.z, z1.w, z2.x, z2.y, z2.z, z2.w, z3.x, z3.y, z3.z, z3.w}; unsigned yw[16];
#pragma unroll
            for (int i = 0; i < 8; ++i) { yw[2 * i] = pk2(o[i].x * rstd * bflo(zz[2 * i]), o[i].y * rstd * bfhi(zz[2 * i])); yw[2 * i + 1] = pk2(o[i].z * rstd * bflo(zz[2 * i + 1]), o[i].w * rstd * bfhi(zz[2 * i + 1])); }
            GAS v4u* yp = (GAS v4u*)(YMIX + (size_t)(b * SEQ + n * 64 + tok) * DM + h * 128 + 32 * part);
            yp[0] = (v4u){yw[0], yw[1], yw[2], yw[3]}; yp[1] = (v4u){yw[4], yw[5], yw[6], yw[7]}; yp[2] = (v4u){yw[8], yw[9], yw[10], yw[11]}; yp[3] = (v4u){yw[12], yw[13], yw[14], yw[15]};
            if (n + 1 < 32) { const GAS v4u* gzp = (const GAS v4u*)(GZ0 + (size_t)(n + 1) * 8192 + tok * 128 + 32 * part); z0 = gzp[0]; z1 = gzp[1]; z2 = gzp[2]; z3 = gzp[3]; }
        }
    } else {
        f32x16 S[4];
#pragma unroll
        for (int i = 0; i < 4; ++i) S[i] = (f32x16){};
        f32x4 u[2][4];
        { const GAS f32x4* up = (const GAS f32x4*)(UF0 + (size_t)(wave * 2) * 1024) + lane;
#pragma unroll
          for (int m2 = 0; m2 < 2; ++m2)
#pragma unroll
              for (int rq = 0; rq < 4; ++rq) u[m2][rq] = up[(m2 * 4 + rq) * 64]; }
        const int w = wave, c = lane & 31, hi = lane >> 5;
        const int decv = __builtin_bit_cast(int, DEC[lane & 31]);
#define GDN_SF(kb_, s_) ({ v4u t_; t_.x = pk2(S[kb_][8 * (s_)], S[kb_][8 * (s_) + 1]); t_.y = pk2(S[kb_][8 * (s_) + 2], S[kb_][8 * (s_) + 3]); t_.z = pk2(S[kb_][8 * (s_) + 4], S[kb_][8 * (s_) + 5]); t_.w = pk2(S[kb_][8 * (s_) + 6], S[kb_][8 * (s_) + 7]); __builtin_bit_cast(bf16x8, t_); })
#define GDN_LD44(dst, base_, f0_, f1_) do { _Pragma("unroll") for (int i_ = 0; i_ < 4; ++i_) { dst[i_] = *(const LAS bf16x8*)(buf + (base_) + ((f0_) + i_) * 1024 + lane * 16); dst[4 + i_] = *(const LAS bf16x8*)(buf + (base_) + ((f1_) + i_) * 1024 + lane * 16); } } while (0)
#define GDN_SB() __builtin_amdgcn_sched_barrier(0)
        for (int n = 0; n < 32; ++n) {
            const LAS unsigned char* buf = lds + ((n & 1) ? SC_BUF1 : SC_BUF0);
            const float dec = __builtin_bit_cast(float, __builtin_amdgcn_readlane(decv, n));
            bf16x8 fa[8], fb[8];
            GDN_LD44(fa, WF_OFF, 0, 8); GDN_LD44(fb, WF_OFF, 4, 12); GDN_SB();
            f32x16 vn[2];
#pragma unroll
            for (int m2 = 0; m2 < 2; ++m2) vn[m2] = (f32x16){};
#pragma unroll
            for (int i = 0; i < 4; ++i) { const bf16x8 Sf = GDN_SF(i >> 1, i & 1); vn[0] = __builtin_amdgcn_mfma_f32_32x32x16_bf16(fa[i], Sf, vn[0], 0, 0, 0); vn[1] = __builtin_amdgcn_mfma_f32_32x32x16_bf16(fa[4 + i], Sf, vn[1], 0, 0, 0); }
            GDN_SB(); GDN_LD44(fa, QGF_OFF, 0, 8); GDN_SB();
#pragma unroll
            for (int i = 0; i < 4; ++i) { const bf16x8 Sf = GDN_SF(2 + (i >> 1), i & 1); vn[0] = __builtin_amdgcn_mfma_f32_32x32x16_bf16(fb[i], Sf, vn[0], 0, 0, 0); vn[1] = __builtin_amdgcn_mfma_f32_32x32x16_bf16(fb[4 + i], Sf, vn[1], 0, 0, 0); }
            GDN_SB(); GDN_LD44(fb, QGF_OFF, 4, 12); GDN_SB();
#pragma unroll
            for (int m2 = 0; m2 < 2; ++m2)
#pragma unroll
                for (int rg = 0; rg < 16; ++rg) vn[m2][rg] += u[m2][rg >> 2][rg & 3];
            bf16x8 Vf[2][2];
#pragma unroll
            for (int kb = 0; kb < 2; ++kb)
#pragma unroll
                for (int s = 0; s < 2; ++s) { v4u t; t.x = pk2(vn[kb][8 * s], vn[kb][8 * s + 1]); t.y = pk2(vn[kb][8 * s + 2], vn[kb][8 * s + 3]); t.z = pk2(vn[kb][8 * s + 4], vn[kb][8 * s + 5]); t.w = pk2(vn[kb][8 * s + 6], vn[kb][8 * s + 7]); Vf[kb][s] = __builtin_bit_cast(bf16x8, t); }
            GDN_SB();
            f32x16 o[2];
#pragma unroll
            for (int m2 = 0; m2 < 2; ++m2) o[m2] = (f32x16){};
#pragma unroll
            for (int i = 0; i < 4; ++i) { const bf16x8 Sf = GDN_SF(i >> 1, i & 1); o[0] = __builtin_amdgcn_mfma_f32_32x32x16_bf16(fa[i], Sf, o[0], 0, 0, 0); o[1] = __builtin_amdgcn_mfma_f32_32x32x16_bf16(fa[4 + i], Sf, o[1], 0, 0, 0); }
            GDN_SB(); GDN_LD44(fa, AF_OFF, 0, 4); GDN_SB();
#pragma unroll
            for (int i = 0; i < 4; ++i) { const bf16x8 Sf = GDN_SF(2 + (i >> 1), i & 1); o[0] = __builtin_amdgcn_mfma_f32_32x32x16_bf16(fb[i], Sf, o[0], 0, 0, 0); o[1] = __builtin_amdgcn_mfma_f32_32x32x16_bf16(fb[4 + i], Sf, o[1], 0, 0, 0); }
            GDN_SB(); GDN_LD44(fb, KDF_OFF, 0, 4); GDN_SB();
#pragma unroll
            for (int i = 0; i < 4; ++i) { o[0] = __builtin_amdgcn_mfma_f32_32x32x16_bf16(fa[i], Vf[i >> 1][i & 1], o[0], 0, 0, 0); o[1] = __builtin_amdgcn_mfma_f32_32x32x16_bf16(fa[4 + i], Vf[i >> 1][i & 1], o[1], 0, 0, 0); }
            GDN_SB(); GDN_LD44(fa, KDF_OFF, 8, 12); GDN_SB();
            asm volatile("s_waitcnt lgkmcnt(0)" ::: "memory"); __builtin_amdgcn_s_barrier(); asm volatile("" ::: "memory");
#pragma unroll
            for (int m2 = 0; m2 < 2; ++m2)
#pragma unroll
                for (int rg = 0; rg < 16; ++rg) Ob[(32 * m2 + crow(rg, hi)) * OB_ST + 32 * w + c] = o[m2][rg];
            GDN_SB();
            if (n + 1 < 32) { const GAS f32x4* up = (const GAS f32x4*)(UF0 + (size_t)(n + 1) * 8192 + (size_t)(w * 2) * 1024) + lane;
#pragma unroll
                for (int m2 = 0; m2 < 2; ++m2)
#pragma unroll
                    for (int rq = 0; rq < 4; ++rq) u[m2][rq] = up[(m2 * 4 + rq) * 64]; }
#pragma unroll
            for (int i = 0; i < 4; ++i) S[i] = S[i] * dec;
#pragma unroll
            for (int i = 0; i < 4; ++i) { S[0] = __builtin_amdgcn_mfma_f32_32x32x16_bf16(fb[i], Vf[i >> 1][i & 1], S[0], 0, 0, 0); S[1] = __builtin_amdgcn_mfma_f32_32x32x16_bf16(fb[4 + i], Vf[i >> 1][i & 1], S[1], 0, 0, 0); }
#pragma unroll
            for (int i = 0; i < 4; ++i) { S[2] = __builtin_amdgcn_mfma_f32_32x32x16_bf16(fa[i], Vf[i >> 1][i & 1], S[2], 0, 0, 0); S[3] = __builtin_amdgcn_mfma_f32_32x32x16_bf16(fa[4 + i], Vf[i >> 1][i & 1], S[3], 0, 0, 0); }
            asm volatile("s_waitcnt lgkmcnt(0)" ::: "memory"); __builtin_amdgcn_s_barrier(); asm volatile("" ::: "memory");
        }
#undef GDN_SF
#undef GDN_LD44
#undef GDN_SB
    }
#undef GDN_DMA
    __syncthreads();
}
}

namespace moba {
constexpr int D = 128, LDK = 7424, LDO = 2048;
constexpr float THR = 8.f; constexpr bool WSKIP = false;
constexpr float SCALE = 0.08838834764831845f;
constexpr int NW = 8, QBLK = 32, KVBLK = 64, QB = NW * QBLK;
constexpr int SHM_V = KVBLK * D * 2, SHM_K = KVBLK * D * 2;
constexpr int LDS_BYTES = 2 * SHM_V + 2 * SHM_K + NW * 64 * 4;
using bf16 = unsigned short;
typedef short bf16x8 __attribute__((ext_vector_type(8)));
typedef short s16x4 __attribute__((ext_vector_type(4)));
typedef float f32x16 __attribute__((ext_vector_type(16)));
typedef float f32x4 __attribute__((ext_vector_type(4)));
typedef unsigned u32x4 __attribute__((ext_vector_type(4)));
template <class A, class Bt> struct same_t { static constexpr bool v = false; };
template <class A> struct same_t<A, A> { static constexpr bool v = true; };
#define KSWZ(row, colB) ((row) * 256 + ((colB) ^ (((row) & 7) << 4)))
#define SBAR() __builtin_amdgcn_sched_barrier(0)
__device__ __forceinline__ int v_st(int k, int c) { const int kk = (k & ~0xC) | ((k & 4) << 1) | ((k & 8) >> 1); return ((kk >> 3) * 4 + (c >> 5)) * 512 + ((kk & 7) * 32 + (c & 31)) * 2; }
__device__ __forceinline__ int v_rd_base(int lane) { return ((lane & 3) << 3) | (((lane >> 2) & 3) << 6) | (((lane >> 4) & 1) << 5) | (((lane >> 5) & 1) << 8); }
constexpr int v_rd_off(int d0, int ks, int half) { return d0 * 512 + ks * 4096 + half * 2048; }
__device__ __forceinline__ int crow(int r, int hi) { return (r & 3) + 8 * (r >> 2) + 4 * hi; }
__device__ __forceinline__ unsigned cvtpk(float lo, float hi) {
    unsigned r; asm volatile("v_cvt_pk_bf16_f32 %0, %1, %2" : "=v"(r) : "v"(lo), "v"(hi)); return r;
}
__device__ __forceinline__ bf16x8 pack8(f32x4 a, f32x4 b) {
    u32x4 w = {cvtpk(a[0], a[1]), cvtpk(a[2], a[3]), cvtpk(b[0], b[1]), cvtpk(b[2], b[3])};
    return *reinterpret_cast<bf16x8*>(&w);
}
template <class T> __device__ __forceinline__ bf16x8 load8(const T* p) {
    if constexpr (same_t<T, float>::v) { return pack8(*(const f32x4*)p, *(const f32x4*)(p + 4)); }
    else { return *reinterpret_cast<const bf16x8*>(p); }
}
__device__ __forceinline__ void mask_tile(f32x16& p0, f32x16& p1, int dq, unsigned W) {
    const float NEG = -__builtin_inff();
#pragma unroll
    for (int r = 0; r < 16; ++r) {
        const int c = (r & 3) + 8 * (r >> 2);
        if ((unsigned)(dq - c) >= W) p0[r] = NEG;
        if ((unsigned)(dq - c - 32) >= W) p1[r] = NEG;
    }
}
__device__ __forceinline__ void partialSM(f32x16& p0, f32x16& p1, float& m_reg, float& mn, float& alpha) {
    float pmax = p0[0]; for (int r = 1; r < 16; ++r) pmax = fmaxf(pmax, p0[r]); for (int r = 0; r < 16; ++r) pmax = fmaxf(pmax, p1[r]);
    { auto rr = __builtin_amdgcn_permlane32_swap(__float_as_uint(pmax), __float_as_uint(pmax), false, false);
      pmax = fmaxf(__uint_as_float(rr[0]), __uint_as_float(rr[1])); }
    constexpr float C2 = 1.4426950408889634f * SCALE;
    if (__builtin_expect(__all((pmax - m_reg) * SCALE <= THR), 1)) { mn = m_reg; alpha = 1.f; }
    else { mn = fmaxf(m_reg, pmax); alpha = __builtin_amdgcn_exp2f((m_reg - mn) * C2); m_reg = mn; }
    const float mnL = -mn * C2;
    for (int r = 0; r < 16; ++r) p0[r] = fmaf(p0[r], C2, mnL); for (int r = 0; r < 16; ++r) p1[r] = fmaf(p1[r], C2, mnL);
    for (int r = 0; r < 16; ++r) p0[r] = __builtin_amdgcn_exp2f(p0[r]);
}
__device__ __forceinline__ void finishSM(f32x16& p0, f32x16& p1, float alpha, float& l_reg, bf16x8& pa0, bf16x8& pa1, bf16x8& pa2, bf16x8& pa3) {
    for (int r = 0; r < 16; ++r) p1[r] = __builtin_amdgcn_exp2f(p1[r]);
    float ps = 0; for (int r = 0; r < 16; ++r) ps += p0[r]; for (int r = 0; r < 16; ++r) ps += p1[r];
    { auto rr = __builtin_amdgcn_permlane32_swap(__float_as_uint(ps), __float_as_uint(ps), false, false);
      ps = __uint_as_float(rr[0]) + __uint_as_float(rr[1]); }
    l_reg = l_reg * alpha + ps;
#define PK4(P, B_, OUT) do { unsigned a0 = cvtpk(P[B_+0], P[B_+1]), a1 = cvtpk(P[B_+2], P[B_+3]);                          \
        unsigned b0 = cvtpk(P[B_+4], P[B_+5]), b1 = cvtpk(P[B_+6], P[B_+7]);                                             \
        auto r0 = __builtin_amdgcn_permlane32_swap(a0, b0, false, false); auto r1 = __builtin_amdgcn_permlane32_swap(a1, b1, false, false); \
        u32x4 w = {r0[0], r1[0], r0[1], r1[1]}; OUT = *reinterpret_cast<bf16x8*>(&w); } while (0)
    PK4(p0, 0, pa0); PK4(p0, 8, pa1); PK4(p1, 0, pa2); PK4(p1, 8, pa3);
#undef PK4
}
template <int KB, bool SK>
__device__ __forceinline__ void qkt(f32x16& p0, f32x16& p1, const char* K_lds, int r32, int hi, const bf16x8* qr, bool act) {
    if (SK && !act) { const float NEG = -__builtin_inff();
#pragma unroll
        for (int r = 0; r < 16; ++r) { p0[r] = NEG; p1[r] = NEG; } return; }
    p0 = f32x16{}; p1 = f32x16{};
    const char* kb[4];
#pragma unroll
    for (int dd = 0; dd < 4; ++dd) kb[dd] = K_lds + KB * SHM_K + KSWZ(r32, (dd * 16 + hi * 8) * 2);
#pragma unroll
    for (int d0 = 0; d0 < 8; ++d0) { const char* a = kb[d0 & 3] + (d0 >> 2) * 128;
        bf16x8 b0 = *reinterpret_cast<const bf16x8*>(a);
        bf16x8 b1 = *reinterpret_cast<const bf16x8*>(a + 32 * 256);
        p0 = __builtin_amdgcn_mfma_f32_32x32x16_bf16(b0, qr[d0], p0, 0, 0, 0);
        p1 = __builtin_amdgcn_mfma_f32_32x32x16_bf16(b1, qr[d0], p1, 0, 0, 0); }
}
template <int VB, bool SK>
__device__ __forceinline__ void pv_tile(f32x16* o, int vb0, bf16x8 pa0, bf16x8 pa1, bf16x8 pa2, bf16x8 pa3, bool act) {
    if (SK && !act) return;
#define TRRD(dst, off) asm volatile("ds_read_b64_tr_b16 %0, %1 offset:%2" : "=&v"(dst) : "v"(vb0), "i"(off) : "memory")
#define PV_D0(d0) do { s16x4 l0, l1, l2, l3, h0, h1, h2, h3; constexpr int b_ = VB * SHM_V + v_rd_off(d0, 0, 0);     \
        TRRD(l0, b_); TRRD(h0, b_ + 2048); TRRD(l1, b_ + 4096); TRRD(h1, b_ + 6144); TRRD(l2, b_ + 8192); TRRD(h2, b_ + 10240); TRRD(l3, b_ + 12288); TRRD(h3, b_ + 14336); \
        asm volatile("s_waitcnt lgkmcnt(0)" ::: "memory"); SBAR();                 \
        o[d0] = __builtin_amdgcn_mfma_f32_32x32x16_bf16(pa0, (bf16x8){l0[0], l0[1], l0[2], l0[3], h0[0], h0[1], h0[2], h0[3]}, o[d0], 0, 0, 0);   \
        o[d0] = __builtin_amdgcn_mfma_f32_32x32x16_bf16(pa1, (bf16x8){l1[0], l1[1], l1[2], l1[3], h1[0], h1[1], h1[2], h1[3]}, o[d0], 0, 0, 0);   \
        o[d0] = __builtin_amdgcn_mfma_f32_32x32x16_bf16(pa2, (bf16x8){l2[0], l2[1], l2[2], l2[3], h2[0], h2[1], h2[2], h2[3]}, o[d0], 0, 0, 0);   \
        o[d0] = __builtin_amdgcn_mfma_f32_32x32x16_bf16(pa3, (bf16x8){l3[0], l3[1], l3[2], l3[3], h3[0], h3[1], h3[2], h3[3]}, o[d0], 0, 0, 0); } while (0)
    PV_D0(0); PV_D0(1); PV_D0(2); PV_D0(3);
#undef PV_D0
#undef TRRD
}

template <class TIn, class TOut> struct BlockRef { const TIn* Q; const TIn* K; const TIn* V; TOut* O; int P0; };
template <class TIn> struct Seam {
    bf16x8 qr[8];
    bf16x8 st_v0, st_v1, st_k0, st_k1; f32x4 sf0, sf1, sf2, sf3;
    f32x4 tq[16];
};
__device__ __forceinline__ int swa_jlo(int P0, int W) { const int lowk = P0 - W + 1; return lowk > 0 ? lowk / KVBLK : 0; }
#define ROW(p, k0, rr) ((p) + (size_t)((k0) + (rr)) * LDK + sc)
#define VMW() asm volatile("s_waitcnt vmcnt(0)" ::: "memory")
#define VMWN(n) asm volatile("s_waitcnt vmcnt(%0)" :: "i"(n) : "memory")
#define SLOAD_H(Kp, Vp, k0) do { S.st_v0 = load8<TIn>(ROW(Vp, k0, sr)); S.st_v1 = load8<TIn>(ROW(Vp, k0, 32 + sr));              \
                         S.st_k0 = load8<TIn>(ROW(Kp, k0, sr)); S.st_k1 = load8<TIn>(ROW(Kp, k0, 32 + sr)); } while (0)
#define SWRITE_HK(bf) do { *(bf16x8*)(K_lds + (bf) * SHM_K + kws) = S.st_k0; *(bf16x8*)(K_lds + (bf) * SHM_K + kws + 32 * 256) = S.st_k1; } while (0)
#define SWRITE_HV(bf) do { *(bf16x8*)(V_lds + (bf) * SHM_V + vst0) = S.st_v0; *(bf16x8*)(V_lds + (bf) * SHM_V + vst1) = S.st_v1; } while (0)
#define SWRITE_H(bf) do { SWRITE_HV(bf); SWRITE_HK(bf); } while (0)
#define SLOAD_F(p, k0) do { S.sf0 = *(const f32x4*)ROW(p, k0, sr); S.sf1 = *(const f32x4*)(ROW(p, k0, sr) + 4);                \
                            S.sf2 = *(const f32x4*)ROW(p, k0, 32 + sr); S.sf3 = *(const f32x4*)(ROW(p, k0, 32 + sr) + 4); } while (0)
#define SWRITE_KF(bf) do { *(bf16x8*)(K_lds + (bf) * SHM_K + kws) = pack8(S.sf0, S.sf1); *(bf16x8*)(K_lds + (bf) * SHM_K + kws + 32 * 256) = pack8(S.sf2, S.sf3); } while (0)
#define SWRITE_VF(bf) do { *(bf16x8*)(V_lds + (bf) * SHM_V + vst0) = pack8(S.sf0, S.sf1); *(bf16x8*)(V_lds + (bf) * SHM_V + vst1) = pack8(S.sf2, S.sf3); } while (0)
template <class TIn, class TOut>
__device__ __forceinline__ void causal_swa_prime(const BlockRef<TIn, TOut>& cur, int W, char* lds, Seam<TIn>& S) {
    constexpr bool F32 = same_t<TIn, float>::v;
    const int tid = threadIdx.x, wid = __builtin_amdgcn_readfirstlane(tid >> 6), lane = tid & 63, r32 = lane & 31, hi = lane >> 5;
    const int sr = tid >> 4, sc = (tid & 15) * 8, kws = KSWZ(sr, sc * 2); char* K_lds = lds + 2 * SHM_V;
    const int kb0 = swa_jlo(cur.P0, W) * KVBLK;
    for (int d0 = 0; d0 < 8; ++d0) S.qr[d0] = load8<TIn>(cur.Q + (size_t)(wid * QBLK + r32) * LDK + d0 * 16 + hi * 8);
    if constexpr (F32) { SLOAD_F((const float*)cur.K, kb0); VMW(); SWRITE_KF(0); SBAR(); SLOAD_F((const float*)cur.V, kb0); }
    else { SLOAD_H(cur.K, cur.V, kb0); VMW(); SWRITE_HK(0); }
    __syncthreads();
}
template <class TIn, class TOut>
__device__ __forceinline__ void causal_swa_block(const BlockRef<TIn, TOut>& cur, const BlockRef<TIn, TOut>& nxt, int skv, int W, char* lds, Seam<TIn>& S, const unsigned pm) {
    const int own_blk = cur.P0 >> 8;
    constexpr bool F32 = same_t<TIn, float>::v;
    const int tid = threadIdx.x, wid = __builtin_amdgcn_readfirstlane(tid >> 6), lane = tid & 63, r32 = lane & 31, hi = lane >> 5;
    const int j_lo = swa_jlo(cur.P0, W);
    int j_hi = (cur.P0 + QB - 1) / KVBLK + 1; if (j_hi > skv / KVBLK) j_hi = skv / KVBLK;
    const int NT = j_hi - j_lo;
    const int kbn = swa_jlo(nxt.P0, W) * KVBLK;
    const int qlo = cur.P0 + wid * QBLK, qm = qlo + r32 - 4 * hi;
    char* V_lds = lds; char* K_lds = lds + 2 * SHM_V;
    float* ws = (float*)(lds + 2 * SHM_V + 2 * SHM_K) + wid * 64; float* li_l = ws, * al_l = ws + 32;
    float m_reg = -1e30f, l_reg = 0; f32x16 o[4] = {};
    const int sr = tid >> 4, sc = (tid & 15) * 8, vst0 = v_st(sr, sc), vst1 = v_st(32 + sr, sc), kws = KSWZ(sr, sc * 2);
    const int vb0 = (int)(uintptr_t)V_lds + v_rd_base(lane);
    const TIn* Kh = cur.K; const TIn* Vh = cur.V;
#define RESC(a) do { if (__any((a) < 1.f)) { if (hi == 0) al_l[r32] = (a); asm volatile("s_waitcnt lgkmcnt(0)" ::: "memory");              \
                     for (int d_ = 0; d_ < 4; ++d_) for (int r = 0; r < 16; ++r) o[d_][r] *= al_l[crow(r, hi)]; } } while (0)
#define KBASE(t) ((j_lo + (t)) * KVBLK)
#define ACT(t) (KBASE(t) <= qlo + QBLK - 1 && KBASE(t) + KVBLK - 1 >= qlo - W + 1)
#define MASKT(P0_, P1_, t) do { const int kb_ = KBASE(t); if ((!SK || ACT(t)) && (kb_ + KVBLK - 1 > qlo || kb_ <= qlo + QBLK - 1 - W)) mask_tile(P0_, P1_, qm - kb_, (unsigned)W); if ((kb_ >> 8) < own_blk) { if (!((pm >> (kb_ >> 8)) & 1u)) { const float NEG_ = -__builtin_inff(); _Pragma("unroll") for (int r_ = 0; r_ < 16; ++r_) { P0_[r_] = NEG_; P1_[r_] = NEG_; } } } } while (0)
    constexpr int NQL = F32 ? 16 : 8;
    constexpr bool SK = WSKIP && !F32;
#define SEAM_K0() do { VMWN(NQL); if constexpr (F32) { SWRITE_KF(0); SBAR(); SLOAD_F((const float*)nxt.V, kbn); } else { SWRITE_HK(0); } SBAR(); } while (0)
    f32x16 pA0, pA1, pB0, pB1; float mnA, mnB, alA, alB; bf16x8 pa0, pa1, pa2, pa3;
    if constexpr (F32) { VMW(); SWRITE_VF(0); SBAR(); } else { SWRITE_HV(0); SBAR(); }
    if (NT > 1) { if constexpr (F32) SLOAD_F((const float*)Kh, KBASE(1)); else SLOAD_H(Kh, Vh, KBASE(1)); }
    SBAR(); qkt<0, SK>(pA0, pA1, K_lds, r32, hi, S.qr, ACT(0));
    if constexpr (F32) { if (NT > 1) { VMW(); SWRITE_KF(1); SBAR(); SLOAD_F((const float*)Vh, KBASE(1)); } }
    MASKT(pA0, pA1, 0); partialSM(pA0, pA1, m_reg, mnA, alA);
    if (NT > 1) { VMW(); if constexpr (F32) { SWRITE_VF(1); SBAR(); if (NT > 2) SLOAD_F((const float*)Kh, KBASE(2)); } else SWRITE_H(1); }
    __syncthreads();
#define HALF_STEP(PX0, PX1, mnX, alX, PY0, PY1, alY, t, KB, VB, SB) do {                                                      \
        SBAR(); qkt<KB, SK>(PX0, PX1, K_lds, r32, hi, S.qr, ACT(t));                                             \
        finishSM(PY0, PY1, alY, l_reg, pa0, pa1, pa2, pa3); SBAR();                                                           \
        if ((t) + 1 < NT) { if constexpr (F32) { VMW(); SWRITE_KF(SB); SBAR(); SLOAD_F((const float*)Vh, KBASE((t) + 1)); }  \
                            else { SLOAD_H(Kh, Vh, KBASE((t) + 1)); } SBAR(); }                                               \
        pv_tile<VB, SK>(o, vb0, pa0, pa1, pa2, pa3, ACT((t) - 1)); MASKT(PX0, PX1, (t)); partialSM(PX0, PX1, m_reg, mnX, alX);                                        \
        __syncthreads();                                                                                                      \
        if ((t) + 1 < NT) { VMW(); if constexpr (F32) { SWRITE_VF(SB); SBAR(); if ((t) + 2 < NT) SLOAD_F((const float*)Kh, KBASE((t) + 2)); } \
                            else { SWRITE_H(SB); } }                                                                          \
        RESC(alX); __syncthreads(); } while (0)
    for (int t = 1; t + 1 < NT; t += 2) {
        HALF_STEP(pB0, pB1, mnB, alB, pA0, pA1, alA, t, 1, 0, 0);
        HALF_STEP(pA0, pA1, mnA, alA, pB0, pB1, alB, t + 1, 0, 1, 1);
    }
    const bool even = (NT & 1) == 0;
    if (even) { SBAR(); qkt<1, SK>(pB0, pB1, K_lds, r32, hi, S.qr, ACT(NT - 1)); SBAR(); }
#define QROW(e) (nxt.Q + (size_t)(wid * QBLK + r32) * LDK + ((e) >> 1) * 16 + hi * 8 + ((e) & 1) * 4)
    if constexpr (F32) { SLOAD_F((const float*)nxt.K, kbn); SBAR();
#pragma unroll
        for (int e = 0; e < 8; ++e) S.tq[e] = *(const f32x4*)QROW(e); }
    else { SLOAD_H(nxt.K, nxt.V, kbn); SBAR();
#pragma unroll
        for (int d0 = 0; d0 < 8; ++d0) S.qr[d0] = load8<TIn>(nxt.Q + (size_t)(wid * QBLK + r32) * LDK + d0 * 16 + hi * 8); }
    SBAR();
    finishSM(pA0, pA1, alA, l_reg, pa0, pa1, pa2, pa3); SBAR();
    if constexpr (F32) {
#pragma unroll
        for (int e = 8; e < 16; ++e) S.tq[e] = *(const f32x4*)QROW(e); SBAR(); }
#undef QROW
    pv_tile<0, SK>(o, vb0, pa0, pa1, pa2, pa3, ACT(even ? NT - 2 : NT - 1));
    if (even) { MASKT(pB0, pB1, NT - 1); partialSM(pB0, pB1, m_reg, mnB, alB); __syncthreads(); RESC(alB);
        finishSM(pB0, pB1, alB, l_reg, pa0, pa1, pa2, pa3); SBAR(); pv_tile<1, SK>(o, vb0, pa0, pa1, pa2, pa3, ACT(NT - 1)); }
    SBAR(); SEAM_K0();
    if (hi == 0) li_l[r32] = l_reg; asm volatile("s_waitcnt lgkmcnt(0)" ::: "memory");
    float rli[16];
#pragma unroll
    for (int r = 0; r < 16; ++r) rli[r] = __builtin_amdgcn_rcpf(li_l[crow(r, hi)]);
    TOut* Ow = cur.O + (size_t)(wid * QBLK) * LDO;
#pragma unroll
    for (int r = 0; r < 16; ++r) { const int orow = crow(r, hi);
#pragma unroll
        for (int d0 = 0; d0 < 4; ++d0) { const float v = o[d0][r] * rli[r];
            if constexpr (same_t<TOut, float>::v) { Ow[(size_t)orow * LDO + d0 * 32 + r32] = v; }
            else { const float vn = __shfl_xor(v, 1);
                   if ((r32 & 1) == 0) *(unsigned*)(Ow + (size_t)orow * LDO + d0 * 32 + r32) = cvtpk(v, vn); } } }
    if constexpr (F32) {
#pragma unroll
        for (int d0 = 0; d0 < 8; ++d0) S.qr[d0] = pack8(S.tq[2 * d0], S.tq[2 * d0 + 1]); }
    __syncthreads();
#undef RESC
#undef KBASE
#undef ACT
#undef MASKT
#undef SEAM_K0
#undef HALF_STEP
}
#undef ROW
#undef VMW
#undef VMWN
#undef SLOAD_H
#undef SWRITE_HK
#undef SWRITE_HV
#undef SWRITE_H
#undef SLOAD_F
#undef SWRITE_KF
#undef SWRITE_VF
__device__ __forceinline__ unsigned select_mask(const bf16x8* qr, const float* km  , int own, int hi) {
    float gate[7];
#pragma unroll
    for (int n = 0; n < 7; ++n) { float p = 0.f;
        if (n < own) {
#pragma unroll
            for (int d0 = 0; d0 < 8; ++d0) { const f32x4 k0 = *(const f32x4*)(km + n * 128 + d0 * 16 + hi * 8), k1 = *(const f32x4*)(km + n * 128 + d0 * 16 + hi * 8 + 4); const bf16x8 q = qr[d0];
                p += __builtin_bit_cast(float, (unsigned)(unsigned short)q[0] << 16) * k0[0] + __builtin_bit_cast(float, (unsigned)(unsigned short)q[1] << 16) * k0[1]
                   + __builtin_bit_cast(float, (unsigned)(unsigned short)q[2] << 16) * k0[2] + __builtin_bit_cast(float, (unsigned)(unsigned short)q[3] << 16) * k0[3]
                   + __builtin_bit_cast(float, (unsigned)(unsigned short)q[4] << 16) * k1[0] + __builtin_bit_cast(float, (unsigned)(unsigned short)q[5] << 16) * k1[1]
                   + __builtin_bit_cast(float, (unsigned)(unsigned short)q[6] << 16) * k1[2] + __builtin_bit_cast(float, (unsigned)(unsigned short)q[7] << 16) * k1[3]; }
            p += __shfl_xor(p, 32); }
        gate[n] = (n < own) ? p : -__builtin_inff(); }
    unsigned pm = 0u;
#pragma unroll
    for (int r = 0; r < 3; ++r) { if (r < own) { int best = 0; float bv = -__builtin_inff(); bool have = false;
#pragma unroll
            for (int n = 0; n < 7; ++n) { const bool cand = (n < own) && !((pm >> n) & 1u); if (cand && (!have || gate[n] > bv)) { bv = gate[n]; best = n; have = true; } }
            pm |= 1u << best; } }
    return pm;
}
__device__ __forceinline__ int moba_units(int c, int& bh, int& q0, int& q1) { bh = c / 6; const int s = c % 6; if (s < 4) { q0 = q1 = 7 - s; return 1; } if (s == 4) { q0 = 0; q1 = 3; } else { q0 = 1; q1 = 2; } return 2; }
__device__ __forceinline__ BlockRef<bf16, bf16> moba_ref(const bf16* PROJ, bf16* YMIX, int bh, int qb) {
    const int b = bh >> 3, h = bh & 7; BlockRef<bf16, bf16> r;
    r.Q = PROJ + (size_t)(b * 2048 + qb * QB) * LDK + 4096 + h * 128; r.K = PROJ + (size_t)(b * 2048) * LDK + 5120 + h * 128; r.V = PROJ + (size_t)(b * 2048) * LDK + 6144 + h * 128;
    r.O = YMIX + (size_t)(b * 2048 + qb * QB) * LDO + 1024 + h * 128; r.P0 = qb * QB; return r;
}
__device__ __forceinline__ void moba_phase(int c, const bf16* PROJ, bf16* YMIX, const float* KM, char* lds) {
    int bh, q0, q1; const int nu = moba_units(c, bh, q0, q1); const int hi = (threadIdx.x & 63) >> 5;
    const float* km = KM + (size_t)bh * 8 * 128;
    BlockRef<bf16, bf16> cur = moba_ref(PROJ, YMIX, bh, q0);
    Seam<bf16> S;
    causal_swa_prime<bf16, bf16>(cur, 1 << 20, lds, S);
    for (int u = 0; u < nu; ++u) {
        const BlockRef<bf16, bf16> nxt = (u + 1 < nu) ? moba_ref(PROJ, YMIX, bh, q1) : cur;
        const unsigned pm = select_mask(S.qr, km, cur.P0 >> 8, hi);
        causal_swa_block<bf16, bf16>(cur, nxt, 2048, 1 << 20, lds, S, pm);
        cur = nxt;
    }
}
}

constexpr int N_PHASES = 12;
__global__ void __launch_bounds__(NTHR, 2) mk_fwd(Args args) {
    extern __shared__ __attribute__((aligned(16))) unsigned char lds_raw[];
    LAS unsigned char* lds = (LAS unsigned char*)lds_raw;
    volatile LAS unsigned* MISC = (volatile LAS unsigned*)(lds + MISC_OFF);
    const int tid = threadIdx.x, lane = tid & 63, wave = __builtin_amdgcn_readfirstlane(tid >> 6);
    const int G = gridDim.x; const int bx = blockIdx.x; const int vcu = (G % 8 == 0) ? (bx % 8) * (G / 8) + bx / 8 : bx;
    const int gw = vcu * NWAVES + wave, NGW = G * NWAVES;
    unsigned char* ws = args.ws; gu32* ctl = (gu32*)(ws + WS_CTL);
    for (int u = tid; u < (LDS_BYTES - LDSCTL_OFF) / 4; u += NTHR) ((LAS unsigned*)(lds + LDSCTL_OFF))[u] = 0u;
    __syncthreads();
    const int lo = args.ph_lo, hi = args.ph_hi;
    const bool one_launch = (hi - lo) > 1;
    XcdBarrier bar; bar.bar = (unsigned*)(ctl + CW_BAR) + args.li * XCD_BAR_WORDS; bar.x = 0; bar.st = nullptr;
    if (one_launch) bar = xcd_barrier_post((unsigned*)(ctl + CW_BAR) + args.li * XCD_BAR_WORDS, MISC + 8);
#define IN(k) (lo <= (k) && (k) < hi)
#define SEAM(k) do { if (IN(k) && IN((k) + 1)) xcd_barrier(bar); } while (0)
    const float* mod = (const float*)(ws + WS_MOD); bf16* H = (bf16*)(ws + WS_H); bf16* ACT = (bf16*)(ws + WS_ACT); float* Y = (float*)(ws + WS_Y); bf16* PROJ = (bf16*)(ws + WS_PROJ); bf16* YMIX = (bf16*)(ws + WS_YMIX);

    if (IN(0)) { rope_table(args, tid); fill_slot(args, lds, tid, lane, wave, bx, G, 0, 128, VI_F1, VI_IN, 3968); adaln_wait(args, 32u, tid);
                 row_pass_first(args, lds, H, gw, NGW, tid, lane); } SEAM(0);
    if (IN(2)) { pg8::Gemm g{H, (const bf16*)(ws + WS_WGU1), M, NGU, DM}; pg8::StaticOrder S; S.init(M, NGU, G, bx); pg8::EpiSwiGLU E{ACT, DFF};
                 pg8::gemm_phase<pg8::EpiSwiGLU, pg8::StaticOrder, true, true>(lds + RING_OFF, g, S, E);
                 if (G == 256 && bx >= 128) fill_slot(args, lds, tid, lane, wave, bx - 128, 128, 128, 192, VI_IN, VI_OUT, 2995); } SEAM(2);
    if (IN(3)) { pg8::Gemm g{ACT, (const bf16*)(ws + WS_WD1), M, DM, DFF}; pg8::StaticOrder S; S.init(M, DM, G, bx);
                 pg8::PanelSS s1{(float*)(ws + WS_XB), (unsigned*)(ctl + CW_PAN)}, s2{(float*)(ws + WS_XB) + 65536, (unsigned*)(ctl + CW_PAN + 2048)};
                 pg8::EpiNormRes<false, true> E{args.in[I_X], ws + WS_XRES, H, mod, args.in[I_F1POST], 2, 0.5f, args.in[I_MPRE], 3, 4, s1, s2};
                 pg8::gemm_phase<pg8::EpiNormRes<false, true>, pg8::StaticOrder, false, true>(lds + RING_OFF, g, S, E); } SEAM(3);
    if (IN(5)) { pg8::Gemm g{H, (const bf16*)(ws + WS_WIN), M, NIN, DM}; pg8::StaticOrder S; S.init(M, NIN, G, bx); pg8::EpiBf16 E{PROJ, NIN};
                 pg8::gemm_phase<pg8::EpiBf16, pg8::StaticOrder, true, true>(lds + RING_OFF, g, S, E);
                 if (G == 256 && bx >= 160) fill_slot(args, lds, tid, lane, wave, bx - 160, 96, 320, 192, VI_F2GU, VI_F2GU + 1408, 1408); } SEAM(5);
    if (IN(6)) { if (wave >= 4 && bx < NB * GDH * 32) gdn::prep_touch(args, bx, tid - 256);
                 if (!(args.norope & 1)) { rope_q_phase(args, gw, NGW, lane); for (int it = bx; it < NB * 8 * 8; it += G) krope_kmean_item(args, it, lds, tid); }
                 for (int it = bx; it < NB * GDH * 32; it += G) gdn::prep_item(args, it, lds, tid, lane, wave); } SEAM(6);
    if (IN(7)) { __syncthreads(); if (bx < 192) { if (!(args.norope & 2)) moba::moba_phase(bx, (const bf16*)PROJ, YMIX, (const float*)(ws + WS_KMEAN), (char*)lds_raw);
                                 if (G == 256 && (bx % 6) >= 3 && !(args.norope & 8)) { __syncthreads(); fill_slot(args, lds, tid, lane, wave, (bx / 6) * 3 + (bx % 6) - 3, 96, 0, 0, VI_OUT, VI_F2GU, VI_F2GU - VI_OUT); fill_slot(args, lds, tid, lane, wave, (bx / 6) * 3 + (bx % 6) - 3, 96, 0, 0, VI_F2GU + 1408, VI_F2GU + 2816, 1408); } }
                 else if (bx < 224) { if (!(args.norope & 4)) gdn::scan_unit(args, bx - 192, lds, tid, lane, wave); }
                 else if (G == 256 && !(args.norope & 8)) fill_slot(args, lds, tid, lane, wave, bx - 224, 32, 0, 0, VI_F2GU + 2816, VI_F2D, VI_F2D - (VI_F2GU + 2816)); } SEAM(7);
    if (IN(8)) { pg8::Gemm g{YMIX, (const bf16*)(ws + WS_WOUT), M, DM, DM}; pg8::StaticOrder S; S.init(M, DM, G, bx);
                 pg8::PanelSS s1{(float*)(ws + WS_XB) + 2 * 65536, (unsigned*)(ctl + CW_PAN + 2 * 2048)}, s2{(float*)(ws + WS_XB) + 3 * 65536, (unsigned*)(ctl + CW_PAN + 3 * 2048)};
                 pg8::EpiNormRes<true, true> E{ws + WS_XRES, ws + WS_XRES, H, mod, args.in[I_MPOST], 5, 1.0f, args.in[I_F2PRE], 6, 7, s1, s2};
                 pg8::gemm_phase<pg8::EpiNormRes<true, true>, pg8::StaticOrder, false, true>(lds + RING_OFF, g, S, E); } SEAM(8);
    if (IN(10)) { pg8::Gemm g{H, (const bf16*)(ws + WS_WGU2), M, NGU, DM}; pg8::StaticOrder S; S.init(M, NGU, G, bx); pg8::EpiSwiGLU E{ACT, DFF};
                  pg8::gemm_phase<pg8::EpiSwiGLU, pg8::StaticOrder, true, true>(lds + RING_OFF, g, S, E);
                  if (G == 256 && bx >= 128) fill_slot(args, lds, tid, lane, wave, bx - 128, 128, 512, 64, VI_F2D, VI_END, 2099); } SEAM(10);
    if (IN(11)) { pg8::Gemm g{ACT, (const bf16*)(ws + WS_WD2), M, DM, DFF}; pg8::StaticOrder S; S.init(M, DM, G, bx);
                  pg8::PanelSS s1{(float*)(ws + WS_XB) + 4 * 65536, (unsigned*)(ctl + CW_PAN + 4 * 2048)};
                  pg8::EpiNormRes<true, false> E{ws + WS_XRES, args.out, nullptr, mod, args.in[I_F2POST], 8, 0.5f, nullptr, 0, 0, s1, s1};
                  pg8::gemm_phase<pg8::EpiNormRes<true, false>, pg8::StaticOrder, false, true>(lds + RING_OFF, g, S, E); }
#undef IN
#undef SEAM
}

extern "C" void kernel_launch(void* const* d_in, const int* in_sizes, int n_in, void* d_out, int out_size, void* d_ws, size_t ws_size, hipStream_t stream) {
    static int grid = 0;
    if (grid == 0) {
        if (n_in != 22 || out_size != M * DM || ws_size < WS_END) { fprintf(stderr, "kernel_launch: unexpected shapes (n_in %d out %d ws %zu)\n", n_in, out_size, ws_size); grid = -1; return; }
        int dev = 0, cus = 0, per_cu = 0;
        if (hipGetDevice(&dev) != hipSuccess || hipDeviceGetAttribute(&cus, hipDeviceAttributeMultiprocessorCount, dev) != hipSuccess) { grid = -1; return; }
        if (hipFuncSetAttribute((const void*)mk_fwd, hipFuncAttributeMaxDynamicSharedMemorySize, LDS_BYTES) != hipSuccess) { fprintf(stderr, "kernel_launch: hipFuncSetAttribute failed\n"); grid = -1; return; }
        if (hipOccupancyMaxActiveBlocksPerMultiprocessor(&per_cu, (const void*)mk_fwd, NTHR, LDS_BYTES) != hipSuccess || per_cu < 1) { fprintf(stderr, "kernel_launch: occupancy query says %d blocks per CU\n", per_cu); per_cu = 1; }
        (void)hipGetLastError();
        grid = cus;
    }
    if (grid < 0) return;
    (void)hipMemsetAsync((char*)d_ws + WS_CTL, 0, CTL_ZERO_BYTES, stream);
    Args a{};
    for (int i = 0; i < 22; ++i) a.in[i] = (const float*)d_in[i];
    a.out = (float*)d_out; a.ws = (unsigned char*)d_ws;
#ifndef PROBE_FLAGS
#define PROBE_FLAGS 0
#endif
#if defined(PROBE_A_LO)
    a.ph_lo = 0; a.ph_hi = PROBE_A_HI; a.li = 0; a.norope = 0; hipLaunchKernelGGL(mk_fwd, dim3(grid), dim3(NTHR), LDS_BYTES, stream, a);
    a.ph_lo = PROBE_A_LO; a.ph_hi = N_PHASES; a.li = 1; a.norope = ((PROBE_A_LO <= 6 && 6 < PROBE_A_HI) ? 1 : 0) | PROBE_FLAGS; hipLaunchKernelGGL(mk_fwd, dim3(grid), dim3(NTHR), LDS_BYTES, stream, a);
#else
    a.ph_lo = 0; a.ph_hi = N_PHASES; a.li = 0; a.norope = 0; hipLaunchKernelGGL(mk_fwd, dim3(grid), dim3(NTHR), LDS_BYTES, stream, a);
#endif
}
```

```cpp
#include <hip/hip_runtime.h>
#include <cstdio>
#include <cstdint>
#include <cmath>
namespace pg8 {
#define PG8_LAS __attribute__((address_space(3)))
typedef unsigned short bf16_t;
typedef short bf16x8 __attribute__((ext_vector_type(8)));
typedef float f32x4 __attribute__((ext_vector_type(4)));
typedef unsigned u32x4 __attribute__((ext_vector_type(4)));
constexpr int BM = 256, BK = 64, HALF = 128, HTB = HALF * BK * 2  , STAGE_BYTES = 8 * HTB, NXCD = 8, WGM = 8;

__host__ __device__ __forceinline__ int lds_byte(int r, int c) { const int st = (r >> 4) * 2 + (c >> 5), rr = r & 15, cc = c & 31, ob = rr * 64 + cc * 2; return st * 1024 + (ob ^ (((ob >> 9) & 1) << 5)); }
__host__ __device__ __forceinline__ void stage_rc(int b, int& R, int& C) { const int st = b / 1024, sb = b % 1024, swz = sb ^ (((sb >> 9) & 1) << 5); R = (st >> 1) * 16 + swz / 64; C = (st & 1) * 32 + (swz % 64) / 2; }
__host__ __device__ __forceinline__ int perm32(int rho) { const int n = rho >> 4, i = rho & 15; return 8 * (i >> 2) + 4 * n + (i & 3); }

struct Unit { int pm, pn; };
struct Gemm { const bf16_t* A; const bf16_t* Bt; int M, N, K; };

struct StaticOrder {
    int nM, nN, nwg, G, c;
    __host__ __device__ void init(int M, int N, int G_, int c_) { nM = M / BM; nN = N / BM; nwg = nM * nN; G = G_; c = c_; }
    __host__ __device__ bool next(int i, Unit& u) const {
        const long L = (long)i * G + c; if (L >= nwg) return false;
        int wgid = (int)L; { const int q = nwg / NXCD, r = nwg % NXCD, xcd = wgid % NXCD, off = wgid / NXCD; wgid = (xcd < r ? xcd * (q + 1) : r * (q + 1) + (xcd - r) * q) + off; }
        const int nig = WGM * nN, gid = wgid / nig, fm = gid * WGM, gsz = (nM - fm) < WGM ? (nM - fm) : WGM;
        u.pm = fm + ((wgid % nig) % gsz); u.pn = (wgid % nig) / gsz; return true;
    }
    __device__ __forceinline__ void a_ready(const Unit&) const {}
    __device__ __forceinline__ void done(const Unit&) const {}
};


__device__ __forceinline__ unsigned cvt_pk_bf16(float lo, float hi) { unsigned r; asm volatile("v_cvt_pk_bf16_f32 %0, %1, %2" : "=v"(r) : "v"(lo), "v"(hi)); return r; }
__device__ __forceinline__ float silu_f(float g) { return g * __builtin_amdgcn_rcpf(1.0f + __builtin_amdgcn_exp2f(g * -1.4426950408889634f)); }

struct EpiBf16 {
    static constexpr bool PERM = true, AFTER_DRAIN = false;
    bf16_t* O; int ldc;
    __device__ __forceinline__ void operator()(const f32x4 (&acc)[2][2][4][2], const Unit& u, int wr, int wc, int fr, int fq) const {
        const int row0 = u.pm * BM + wr * 64 + fr; const int col0 = u.pn * BM + wc * 32 + 8 * fq;
#pragma unroll
        for (int ai = 0; ai < 2; ++ai)
#pragma unroll
            for (int m = 0; m < 4; ++m) { bf16_t* rowp = O + (size_t)(row0 + ai * HALF + m * 16) * ldc + col0;
#pragma unroll
                for (int bj = 0; bj < 2; ++bj) { const f32x4 v0 = acc[ai][bj][m][0], v1 = acc[ai][bj][m][1];
                    u32x4 w; w.x = cvt_pk_bf16(v0[0], v0[1]); w.y = cvt_pk_bf16(v0[2], v0[3]); w.z = cvt_pk_bf16(v1[0], v1[1]); w.w = cvt_pk_bf16(v1[2], v1[3]);
                    *(u32x4*)(rowp + bj * HALF) = w; } }
    }
};
struct EpiSwiGLU {
    static constexpr bool PERM = true, AFTER_DRAIN = false;
    bf16_t* O; int ldc;
    __device__ __forceinline__ void operator()(const f32x4 (&acc)[2][2][4][2], const Unit& u, int wr, int wc, int fr, int fq) const {
        const int row0 = u.pm * BM + wr * 64 + fr; const int col0 = u.pn * HALF + wc * 32 + 8 * fq;
#pragma unroll
        for (int ai = 0; ai < 2; ++ai)
#pragma unroll
            for (int m = 0; m < 4; ++m) { bf16_t* rowp = O + (size_t)(row0 + ai * HALF + m * 16) * ldc + col0;
                const f32x4 g0 = acc[ai][0][m][0], g1 = acc[ai][0][m][1], u0 = acc[ai][1][m][0], u1 = acc[ai][1][m][1];
                u32x4 w;
                w.x = cvt_pk_bf16(silu_f(g0[0]) * u0[0], silu_f(g0[1]) * u0[1]); w.y = cvt_pk_bf16(silu_f(g0[2]) * u0[2], silu_f(g0[3]) * u0[3]);
                w.z = cvt_pk_bf16(silu_f(g1[0]) * u1[0], silu_f(g1[1]) * u1[1]); w.w = cvt_pk_bf16(silu_f(g1[2]) * u1[2], silu_f(g1[3]) * u1[3]);
                *(u32x4*)rowp = w; }
    }
};
struct EpiF32 {
    static constexpr bool PERM = false, AFTER_DRAIN = false;
    float* C; int ldc;
    __device__ __forceinline__ void operator()(const f32x4 (&acc)[2][2][4][2], const Unit& u, int wr, int wc, int fr, int fq) const {
        const int row0 = u.pm * BM + wr * 64 + fr, col0 = u.pn * BM + wc * 32 + 4 * fq;
#pragma unroll
        for (int ai = 0; ai < 2; ++ai)
#pragma unroll
            for (int m = 0; m < 4; ++m) { float* rowp = C + (size_t)(row0 + ai * HALF + m * 16) * ldc + col0;
#pragma unroll
                for (int bj = 0; bj < 2; ++bj)
#pragma unroll
                    for (int n = 0; n < 2; ++n) *(f32x4*)(rowp + bj * HALF + n * 16) = acc[ai][bj][m][n]; }
    }
};
struct PanelSS {
    float* xbuf;
    unsigned* cnt;
    __device__ __forceinline__ void run(const f32x4 (&v)[2][2][4][2], const Unit& u, int wr, int wc, int fr, int fq, PG8_LAS unsigned char* lds, int wid, int lane) const {
        PG8_LAS float* P = (PG8_LAS float*)lds;
        PG8_LAS float* S = (PG8_LAS float*)(lds + 8192);
#pragma unroll
        for (int ai = 0; ai < 2; ++ai)
#pragma unroll
            for (int m = 0; m < 4; ++m) { float s = 0.f;
#pragma unroll
                for (int bj = 0; bj < 2; ++bj)
#pragma unroll
                    for (int n = 0; n < 2; ++n) { const f32x4 x = v[ai][bj][m][n]; s += (x[0] * x[0] + x[1] * x[1]) + (x[2] * x[2] + x[3] * x[3]); }
                s += __shfl_xor(s, 16); s += __shfl_xor(s, 32);
                if (fq == 0) P[(ai * HALF + wr * 64 + m * 16 + fr) * 4 + wc] = s; }
        asm volatile("s_waitcnt lgkmcnt(0)" ::: "memory"); __builtin_amdgcn_s_barrier(); asm volatile("" ::: "memory");
        const int row = wid * 32 + (lane & 31);
        if (lane < 32) { const float t = (P[row * 4 + 0] + P[row * 4 + 1]) + (P[row * 4 + 2] + P[row * 4 + 3]);
            __hip_atomic_store((unsigned*)xbuf + ((size_t)(u.pm * BM + row) * 8 + u.pn), __builtin_bit_cast(unsigned, t), __ATOMIC_RELAXED, __HIP_MEMORY_SCOPE_AGENT); }
        asm volatile("s_waitcnt vmcnt(0)" ::: "memory");
        if (lane == 0) __hip_atomic_fetch_add(cnt + 64 * u.pm, 1u, __ATOMIC_RELAXED, __HIP_MEMORY_SCOPE_AGENT);
        if (wid == 0) {
            unsigned sp = 0;
            while ((unsigned)__builtin_amdgcn_readfirstlane(__hip_atomic_load(cnt + 64 * u.pm, __ATOMIC_RELAXED, __HIP_MEMORY_SCOPE_AGENT)) < 64u) { __builtin_amdgcn_s_sleep(2); if (++sp > (1u << 22)) break; }
        }
        asm volatile("s_waitcnt vmcnt(0) lgkmcnt(0)" ::: "memory"); __builtin_amdgcn_s_barrier(); asm volatile("" ::: "memory");
        if (lane < 32) { const unsigned* slot = (const unsigned*)xbuf + (size_t)(u.pm * BM + row) * 8; float t = 0.f;
#pragma unroll
            for (int k = 0; k < 8; ++k) t += __builtin_bit_cast(float, __hip_atomic_load(slot + k, __ATOMIC_RELAXED, __HIP_MEMORY_SCOPE_AGENT));
            S[row] = t; }
        asm volatile("s_waitcnt lgkmcnt(0)" ::: "memory"); __builtin_amdgcn_s_barrier(); asm volatile("" ::: "memory");
    }
};
template <bool XIN_BF, bool XOUT_BF>
struct EpiNormRes {
    static constexpr bool PERM = true, AFTER_DRAIN = true;
    const void* xr; void* xo; bf16_t* Hout; const float* mod; const float* post_g; int i_ga; float gscale; const float* pre_g; int i_sh, i_sc; PanelSS st1, st2;
    __device__ __forceinline__ static void ldx(const void* base, size_t off, f32x4& a, f32x4& b) {
        if constexpr (XIN_BF) { const u32x4 w = *(const u32x4*)((const bf16_t*)base + off);
            a = (f32x4){__builtin_bit_cast(float, w.x << 16), __builtin_bit_cast(float, w.x & 0xffff0000u), __builtin_bit_cast(float, w.y << 16), __builtin_bit_cast(float, w.y & 0xffff0000u)};
            b = (f32x4){__builtin_bit_cast(float, w.z << 16), __builtin_bit_cast(float, w.z & 0xffff0000u), __builtin_bit_cast(float, w.w << 16), __builtin_bit_cast(float, w.w & 0xffff0000u)}; }
        else { a = *(const f32x4*)((const float*)base + off); b = *(const f32x4*)((const float*)base + off + 4); }
    }
    __device__ __forceinline__ void fused(f32x4 (&acc)[2][2][4][2], const Unit& u, int wr, int wc, int fr, int fq, PG8_LAS unsigned char* lds, int wid, int lane) const {
        const PG8_LAS float* S = (const PG8_LAS float*)(lds + 8192);
        const int col0 = u.pn * BM + wc * 32 + 8 * fq; const float* modb = mod + (size_t)(u.pm >> 3) * (9 * 2048);
        f32x4 pre[4][2][2];
#pragma unroll
        for (int m = 0; m < 4; ++m) { const size_t off = (size_t)(u.pm * BM + wr * 64 + m * 16 + fr) * 2048 + col0;
#pragma unroll
            for (int bj = 0; bj < 2; ++bj) ldx(xr, off + bj * HALF, pre[m][bj][0], pre[m][bj][1]); }
        st1.run(acc, u, wr, wc, fr, fq, lds, wid, lane);
        { f32x4 gg[2][2];
#pragma unroll
          for (int bj = 0; bj < 2; ++bj)
#pragma unroll
              for (int n = 0; n < 2; ++n) gg[bj][n] = (*(const f32x4*)(post_g + col0 + bj * HALF + n * 4)) * (*(const f32x4*)(modb + i_ga * 2048 + col0 + bj * HALF + n * 4)) * gscale;
#pragma unroll
          for (int ai = 0; ai < 2; ++ai)
#pragma unroll
              for (int m = 0; m < 4; ++m) { const int r = ai * HALF + wr * 64 + m * 16 + fr; const float rstd = 1.0f / sqrtf(S[r] * (1.0f / 2048.0f) + 1e-6f); const size_t off = (size_t)(u.pm * BM + r) * 2048 + col0;
#pragma unroll
                  for (int bj = 0; bj < 2; ++bj) { f32x4 x0, x1; if (ai == 0) { x0 = pre[m][bj][0]; x1 = pre[m][bj][1]; } else ldx(xr, off + bj * HALF, x0, x1);
                      f32x4 o0 = x0 + gg[bj][0] * (acc[ai][bj][m][0] * rstd), o1 = x1 + gg[bj][1] * (acc[ai][bj][m][1] * rstd);
                      if constexpr (XOUT_BF) { u32x4 w; w.x = cvt_pk_bf16(o0[0], o0[1]); w.y = cvt_pk_bf16(o0[2], o0[3]); w.z = cvt_pk_bf16(o1[0], o1[1]); w.w = cvt_pk_bf16(o1[2], o1[3]); *(u32x4*)((bf16_t*)xo + off + bj * HALF) = w;
                          o0 = (f32x4){__builtin_bit_cast(float, w.x << 16), __builtin_bit_cast(float, w.x & 0xffff0000u), __builtin_bit_cast(float, w.y << 16), __builtin_bit_cast(float, w.y & 0xffff0000u)};
                          o1 = (f32x4){__builtin_bit_cast(float, w.z << 16), __builtin_bit_cast(float, w.z & 0xffff0000u), __builtin_bit_cast(float, w.w << 16), __builtin_bit_cast(float, w.w & 0xffff0000u)}; }
                      else { *(f32x4*)((float*)xo + off + bj * HALF) = o0; *(f32x4*)((float*)xo + off + bj * HALF + 4) = o1; }
                      acc[ai][bj][m][0] = o0; acc[ai][bj][m][1] = o1; }
                  asm volatile("" : "+v"(acc[ai][0][m][0]), "+v"(acc[ai][0][m][1]), "+v"(acc[ai][1][m][0]), "+v"(acc[ai][1][m][1]));
                  if (ai == 0 && m == 3) asm volatile("" ::: "memory"); } }
        if (Hout) {
            st2.run(acc, u, wr, wc, fr, fq, lds, wid, lane);
            f32x4 ga[2][2], sh[2][2];
#pragma unroll
            for (int bj = 0; bj < 2; ++bj)
#pragma unroll
                for (int n = 0; n < 2; ++n) { ga[bj][n] = (*(const f32x4*)(pre_g + col0 + bj * HALF + n * 4)) * ((*(const f32x4*)(modb + i_sc * 2048 + col0 + bj * HALF + n * 4)) + 1.0f); sh[bj][n] = *(const f32x4*)(modb + i_sh * 2048 + col0 + bj * HALF + n * 4); }
#pragma unroll
            for (int ai = 0; ai < 2; ++ai)
#pragma unroll
                for (int m = 0; m < 4; ++m) { const int r = ai * HALF + wr * 64 + m * 16 + fr; const float rstd = 1.0f / sqrtf(S[r] * (1.0f / 2048.0f) + 1e-6f); const size_t off = (size_t)(u.pm * BM + r) * 2048 + col0;
#pragma unroll
                    for (int bj = 0; bj < 2; ++bj) { const f32x4 h0 = (acc[ai][bj][m][0] * rstd) * ga[bj][0] + sh[bj][0], h1 = (acc[ai][bj][m][1] * rstd) * ga[bj][1] + sh[bj][1];
                        u32x4 w; w.x = cvt_pk_bf16(h0[0], h0[1]); w.y = cvt_pk_bf16(h0[2], h0[3]); w.z = cvt_pk_bf16(h1[0], h1[1]); w.w = cvt_pk_bf16(h1[2], h1[3]); *(u32x4*)(Hout + off + bj * HALF) = w; }
                    if (m & 1) asm volatile("" ::: "memory"); }
        }
    }
};

template <class Epi, class Sched, bool ALIGN_EPI = false, bool SP2 = false>
__device__ __forceinline__ void gemm_phase(PG8_LAS unsigned char* lds, const Gemm g, const Sched& S, const Epi& E) {
    const int tid = threadIdx.x, wid = __builtin_amdgcn_readfirstlane(tid >> 6), lane = tid & 63, wr = wid >> 2, wc = wid & 3, fr = lane & 15, fq = lane >> 4;
    const int K = g.K, nt = K / BK;
    unsigned voffA[2], voffB[2];
#pragma unroll
    for (int i = 0; i < 2; ++i) { int R, C; stage_rc(tid * 16 + i * 8192, R, C); const int Rb = Epi::PERM ? ((R & ~31) + perm32(R & 31)) : R;
        voffA[i] = (unsigned)(R * K + C) * 2u; voffB[i] = (unsigned)(Rb * K + C) * 2u; }
    const size_t kstep = (size_t)(BK * 2);
    const size_t hstep = (size_t)HALF * K * 2;
    const size_t tstep = 2 * hstep;
    const unsigned ldsw = (unsigned)wid * 1024u;
    const int aoff = lds_byte(wr * 64 + fr, fq * 8), boff = lds_byte(wc * 32 + fr, fq * 8);
#define PG8_SA(b, h) (((b) * 2 + (h)) * HTB)
#define PG8_SB(b, h) ((4 + (b) * 2 + (h)) * HTB)
#define PG8_STAGE(bufoff, gbase, voff) do { _Pragma("unroll") for (int _i = 0; _i < 2; ++_i) \
        __builtin_amdgcn_global_load_lds((const unsigned*)((const char*)(gbase) + (voff)[_i]), (PG8_LAS unsigned*)(lds + (bufoff) + ldsw + _i * 8192), 16, 0, 0); } while (0)
#define PG8_LDA(dst, b, h) do { _Pragma("unroll") for (int m = 0; m < 4; ++m) _Pragma("unroll") for (int k = 0; k < 2; ++k) dst[m][k] = *(const PG8_LAS bf16x8*)(lds + PG8_SA(b, h) + aoff + m * 2048 + k * 1024); } while (0)
#define PG8_LDB(dst, b, h) do { _Pragma("unroll") for (int n = 0; n < 2; ++n) _Pragma("unroll") for (int k = 0; k < 2; ++k) dst[n][k] = *(const PG8_LAS bf16x8*)(lds + PG8_SB(b, h) + boff + n * 2048 + k * 1024); } while (0)
#define PG8_MMA(ai, bj, At, Bt) do { __builtin_amdgcn_s_setprio(1); _Pragma("unroll") for (int m = 0; m < 4; ++m) _Pragma("unroll") for (int n = 0; n < 2; ++n) _Pragma("unroll") for (int k = 0; k < 2; ++k) \
        acc[ai][bj][m][n] = __builtin_amdgcn_mfma_f32_16x16x32_bf16(Bt[n][k], At[m][k], acc[ai][bj][m][n], 0, 0, 0); __builtin_amdgcn_s_setprio(0); } while (0)
#define PG8_WAIT_V(n) asm volatile("s_waitcnt vmcnt(" #n ")" ::: "memory")
#define PG8_WAIT_L(n) asm volatile("s_waitcnt lgkmcnt(" #n ")" ::: "memory")
#define PG8_BAR __builtin_amdgcn_s_barrier()
#define PG8_SCHED __builtin_amdgcn_sched_barrier(0)
    Unit cur, nxt; int ui = 0;
    if (!S.next(0, cur)) return;
    f32x4 acc[2][2][4][2];
#pragma unroll
    for (int a = 0; a < 2; ++a)
#pragma unroll
        for (int b = 0; b < 2; ++b)
#pragma unroll
            for (int m = 0; m < 4; ++m)
#pragma unroll
                for (int n = 0; n < 2; ++n) acc[a][b][m][n] = (f32x4){0.f, 0.f, 0.f, 0.f};
    bf16x8 At[4][2], B0[2][2], B1[2][2];
    const char* cA = (const char*)g.A + (size_t)cur.pm * tstep; const char* cB = (const char*)g.Bt + (size_t)cur.pn * tstep;
    S.a_ready(cur);
    if constexpr (SP2) {
        PG8_STAGE(PG8_SB(0, 0), cB, voffB); PG8_STAGE(PG8_SB(0, 1), cB + hstep, voffB); PG8_STAGE(PG8_SA(0, 0), cA, voffA); PG8_STAGE(PG8_SA(0, 1), cA + hstep, voffA);
        if (wr == 1) PG8_BAR;
        PG8_WAIT_V(2); PG8_BAR;
        PG8_STAGE(PG8_SB(1, 0), cB + kstep, voffB); PG8_STAGE(PG8_SA(1, 0), cA + kstep, voffA); PG8_STAGE(PG8_SB(1, 1), cB + hstep + kstep, voffB);
        PG8_WAIT_V(6); PG8_BAR;
    } else {
        PG8_STAGE(PG8_SB(0, 0), cB, voffB); PG8_STAGE(PG8_SA(0, 0), cA, voffA); PG8_STAGE(PG8_SB(0, 1), cB + hstep, voffB); PG8_STAGE(PG8_SA(0, 1), cA + hstep, voffA);
        if (wr == 1) PG8_BAR;
        PG8_WAIT_V(4); PG8_BAR;
        PG8_STAGE(PG8_SB(1, 0), cB + kstep, voffB); PG8_STAGE(PG8_SA(1, 0), cA + kstep, voffA); PG8_STAGE(PG8_SB(1, 1), cB + hstep + kstep, voffB);
        PG8_WAIT_V(6); PG8_BAR;
    }
    for (;;) {
        const bool has_next = S.next(ui + 1, nxt);
        const char* nA = has_next ? (const char*)g.A + (size_t)nxt.pm * tstep : cA; const char* nB = has_next ? (const char*)g.Bt + (size_t)nxt.pn * tstep : cB;
        asm volatile(".p2align 8" ::: "memory");
        for (int t = 0; t < nt; t += 2) {
            const bool last = (t == nt - 2);
            const char* a1 = cA + (size_t)(t + 1) * kstep;
            const char* a2 = last ? nA : cA + (size_t)(t + 2) * kstep; const char* b2 = last ? nB : cB + (size_t)(t + 2) * kstep;
            const char* a3 = a2 + kstep; const char* b3 = b2 + kstep;
            if (last && has_next) S.a_ready(nxt);
            if constexpr (SP2) {
            PG8_LDB(B0, 0, 0); PG8_LDB(B1, 0, 1); PG8_SCHED; PG8_LDA(At, 0, 0); PG8_STAGE(PG8_SA(1, 1), a1 + hstep, voffA);
            PG8_WAIT_V(8); PG8_WAIT_L(0); PG8_BAR; PG8_MMA(0, 0, At, B0); PG8_MMA(0, 1, At, B1); PG8_BAR; PG8_SCHED;
            PG8_LDA(At, 0, 1); PG8_STAGE(PG8_SB(0, 0), b2, voffB); PG8_STAGE(PG8_SB(0, 1), b2 + hstep, voffB); PG8_STAGE(PG8_SA(0, 0), a2, voffA);
            PG8_WAIT_V(8); PG8_WAIT_L(0); PG8_BAR; PG8_MMA(1, 0, At, B0); PG8_MMA(1, 1, At, B1); PG8_BAR; PG8_SCHED;
            PG8_LDB(B0, 1, 0); PG8_LDB(B1, 1, 1); PG8_SCHED; PG8_LDA(At, 1, 0); PG8_STAGE(PG8_SA(0, 1), a2 + hstep, voffA);
            PG8_WAIT_V(8); PG8_WAIT_L(0); PG8_BAR; PG8_MMA(0, 0, At, B0); PG8_MMA(0, 1, At, B1); PG8_BAR; PG8_SCHED;
            PG8_LDA(At, 1, 1); PG8_STAGE(PG8_SB(1, 0), b3, voffB); PG8_STAGE(PG8_SB(1, 1), b3 + hstep, voffB); PG8_STAGE(PG8_SA(1, 0), a3, voffA);
            PG8_WAIT_V(8); PG8_WAIT_L(0); PG8_BAR; PG8_MMA(1, 0, At, B0); PG8_MMA(1, 1, At, B1); PG8_BAR; PG8_SCHED;
            } else {
            PG8_LDB(B0, 0, 0); PG8_SCHED; PG8_LDA(At, 0, 0); PG8_STAGE(PG8_SA(1, 1), a1 + hstep, voffA);
            PG8_WAIT_L(8); PG8_BAR; PG8_WAIT_L(0); PG8_MMA(0, 0, At, B0); PG8_BAR; PG8_SCHED;
            PG8_LDB(B1, 0, 1); PG8_STAGE(PG8_SB(0, 0), b2, voffB);
            PG8_BAR; PG8_WAIT_L(0); PG8_MMA(0, 1, At, B1); PG8_BAR;
            PG8_LDA(At, 0, 1); PG8_STAGE(PG8_SA(0, 0), a2, voffA);
            PG8_BAR; PG8_WAIT_L(0); PG8_MMA(1, 0, At, B0); PG8_BAR; PG8_SCHED;
            PG8_STAGE(PG8_SB(0, 1), b2 + hstep, voffB);
            PG8_WAIT_V(6); PG8_BAR; PG8_MMA(1, 1, At, B1); PG8_BAR;
            PG8_LDB(B0, 1, 0); PG8_SCHED; PG8_LDA(At, 1, 0); PG8_STAGE(PG8_SA(0, 1), a2 + hstep, voffA);
            PG8_WAIT_L(8); PG8_BAR; PG8_WAIT_L(0); PG8_MMA(0, 0, At, B0); PG8_BAR; PG8_SCHED;
            PG8_LDB(B1, 1, 1); PG8_STAGE(PG8_SB(1, 0), b3, voffB);
            PG8_BAR; PG8_WAIT_L(0); PG8_MMA(0, 1, At, B1); PG8_BAR;
            PG8_LDA(At, 1, 1); PG8_STAGE(PG8_SA(1, 0), a3, voffA);
            PG8_BAR; PG8_WAIT_L(0); PG8_MMA(1, 0, At, B0); PG8_BAR; PG8_SCHED;
            PG8_STAGE(PG8_SB(1, 1), b3 + hstep, voffB);
            PG8_WAIT_V(6); PG8_BAR; PG8_MMA(1, 1, At, B1); PG8_BAR;
            }
        }
        if constexpr (ALIGN_EPI) { if (wr == 0) PG8_BAR; }
        if constexpr (!Epi::AFTER_DRAIN) { E(acc, cur, wr, wc, fr, fq); S.done(cur); }
        if (!has_next) break;
#pragma unroll
        for (int a = 0; a < 2; ++a)
#pragma unroll
            for (int b = 0; b < 2; ++b)
#pragma unroll
                for (int m = 0; m < 4; ++m)
#pragma unroll
                    for (int n = 0; n < 2; ++n) acc[a][b][m][n] = (f32x4){0.f, 0.f, 0.f, 0.f};
        cur = nxt; cA = nA; cB = nB; ++ui;
        if constexpr (ALIGN_EPI) { if (wr == 1) PG8_BAR; }
    }
    PG8_WAIT_V(0);
    if constexpr (!ALIGN_EPI) { if (wr == 0) PG8_BAR; }
    PG8_BAR;
    if constexpr (Epi::AFTER_DRAIN) { E.fused(acc, cur, wr, wc, fr, fq, lds, wid, lane); S.done(cur); }
#undef PG8_SA
#undef PG8_SB
#undef PG8_STAGE
#undef PG8_LDA
#undef PG8_LDB
#undef PG8_MMA
#undef PG8_WAIT_V
#undef PG8_WAIT_L
#undef PG8_BAR
#undef PG8_SCHED
}
}

constexpr int NWAVES = 8, NTHR = 512;
constexpr int DM = 2048, NB = 4, SEQ = 2048, M = NB * SEQ, DFF = 5632, NGU = 2 * DFF, NIN = 7424, NMOD = 9, NMODC = NMOD * DM;
constexpr int INC = 7184;
constexpr int GDH = 8, HD = 128, GDW = 1024, CONVC = 3072;
constexpr float EPS = 1e-6f;
constexpr int PC_GZ = 3072, PC_MQ = 4096, PC_MK = 5120, PC_MV = 6144, PC_A = 7168, PC_B = 7176;

constexpr size_t MiB = 1u << 20;
constexpr size_t WS_CTL = 0, CTL_ZERO_BYTES = 160 * 1024;
constexpr size_t WS_MOD = 1 * MiB, WS_ROPE = 1 * MiB + 512 * 1024, WS_KMEAN = 1 * MiB + 768 * 1024, WS_GB = 2 * MiB;
constexpr size_t WS_WGU1 = 4 * MiB, WS_WD1 = 48 * MiB, WS_WIN = 70 * MiB, WS_WOUT = 99 * MiB, WS_WGU2 = 107 * MiB, WS_WD2 = 151 * MiB;
constexpr size_t WS_H = 176 * MiB, WS_ACT = 208 * MiB, WS_YMIX = 208 * MiB, WS_Y = 296 * MiB, WS_OG = 296 * MiB, WS_PROJ = 360 * MiB, WS_OPS = 476 * MiB, WS_UF = 532 * MiB, WS_GZ = 296 * MiB, WS_XRES = 328 * MiB, WS_DEC = 2 * MiB, WS_END = 572 * MiB;
constexpr int CW_TMO = 0, CW_CODE = 1, CW_ADA = 2048, CW_BAR = 4096, CW_PAN = 16384, CW_PREP = 32768, CW_ROPE = 34816;
constexpr size_t WS_APART = 2 * MiB + 128 * 1024;
constexpr size_t WS_XB = 2 * MiB + 512 * 1024;

constexpr int RING_OFF = 0, RING_BYTES = 151552;
constexpr int LDSCTL_OFF = RING_BYTES + 1024, MISC_OFF = LDSCTL_OFF + 320;
constexpr int LDS_BYTES = LDSCTL_OFF + 4096;

#define GAS __attribute__((address_space(1)))
#define LAS __attribute__((address_space(3)))
typedef unsigned short bf16;
typedef unsigned v4u __attribute__((ext_vector_type(4)));
typedef unsigned v2u __attribute__((ext_vector_type(2)));
typedef float f32x4 __attribute__((ext_vector_type(4)));
typedef float f32x2 __attribute__((ext_vector_type(2)));
typedef short bf16x8 __attribute__((ext_vector_type(8)));
typedef GAS unsigned gu32;
#define RLX_AGENT __ATOMIC_RELAXED, __HIP_MEMORY_SCOPE_AGENT
#define LDS_WAIT() asm volatile("s_waitcnt lgkmcnt(0)" ::: "memory")
#define VM_WAIT() asm volatile("s_waitcnt vmcnt(0)" ::: "memory")
__device__ __forceinline__ unsigned f2bf(float f) { unsigned u = __builtin_bit_cast(unsigned, f); return (u + 0x7fffu + ((u >> 16) & 1u)) >> 16; }
typedef __bf16 bf16x2_hw __attribute__((ext_vector_type(2)));
__device__ __forceinline__ unsigned pk2(float lo, float hi) { const f32x2 v = {lo, hi}; const bf16x2_hw b = __builtin_convertvector(v, bf16x2_hw); return __builtin_bit_cast(unsigned, b); }
__device__ __forceinline__ float bf2f(unsigned short h) { return __builtin_bit_cast(float, (unsigned)h << 16); }
__device__ __forceinline__ float bflo(unsigned w) { return __builtin_bit_cast(float, w << 16); }
__device__ __forceinline__ float bfhi(unsigned w) { return __builtin_bit_cast(float, w & 0xffff0000u); }
__device__ __forceinline__ float wave_sum(float v) {
#pragma unroll
    for (int o = 1; o < 64; o <<= 1) v += __shfl_xor(v, o);
    return v;
}
__device__ __forceinline__ float wave_max(float v) {
#pragma unroll
    for (int o = 1; o < 64; o <<= 1) v = fmaxf(v, __shfl_xor(v, o));
    return v;
}
__device__ __forceinline__ float silu_acc(float x) { return x / (1.0f + expf(-x)); }
__device__ __forceinline__ float silu_fast(float x) { return x * __builtin_amdgcn_rcpf(1.0f + __builtin_amdgcn_exp2f(x * -1.4426950408889634f)); }

#define XB_TMO      128
#define XB_XCNT(j)  (256  + 64 * (j))
#define XB_XSUB(j)  (1280 + 64 * (j))
#define XB_XGEN(j)  (2304 + 64 * (j))
#define XB_TOP      3328
#define XB_TOPGEN   3392
#define XCD_BAR_WORDS 3456
#define XB_SPIN_CAP (1u << 18)

__device__ __forceinline__ unsigned xb_ld(unsigned* p)              { return __hip_atomic_load(p, __ATOMIC_RELAXED, __HIP_MEMORY_SCOPE_AGENT); }
__device__ __forceinline__ unsigned xb_add(unsigned* p, unsigned v) { return __hip_atomic_fetch_add(p, v, __ATOMIC_RELAXED, __HIP_MEMORY_SCOPE_AGENT); }
__device__ __forceinline__ unsigned xb_xcc_id() { return (unsigned)__builtin_amdgcn_s_getreg((3 << 11) | 20) & 0xFu; }
#define XB_SPIN(cond, bar) do { unsigned _sp = 0; while (cond) { __builtin_amdgcn_s_sleep(1); \
    if ((++_sp & 255u) == 0u) { if (xb_ld(&(bar)[XB_TMO])) break; if (_sp > XB_SPIN_CAP) { atomicAdd(&(bar)[XB_TMO], 1u); break; } } } } while (0)

struct XcdBarrier {
    unsigned* bar; unsigned x;
    volatile LAS unsigned* st;
};

__device__ __forceinline__ XcdBarrier xcd_barrier_post(unsigned* bar, volatile LAS unsigned* st) {
    XcdBarrier b; b.bar = bar; b.x = xb_xcc_id(); b.st = st;
    if (threadIdx.x == 0) (void)xb_add(&bar[XB_XCNT(b.x)], 1u);
    return b;
}
__device__ __forceinline__ void xcd_barrier_complete(unsigned* bar, unsigned x, unsigned& nloc, unsigned& nx) {
    const unsigned G = gridDim.x * gridDim.y * gridDim.z;
    unsigned sum, cnt, mine, sp = 0u;
    for (;;) {
        sum = 0u; cnt = 0u; mine = 0u;
#pragma unroll
        for (unsigned j = 0; j < 16; ++j) { const unsigned c = xb_ld(&bar[XB_XCNT(j)]); sum += c; cnt += (c > 0u) ? 1u : 0u; mine = (j == x) ? c : mine; }
        if (sum == G) break;
        __builtin_amdgcn_s_sleep(1);
        if ((++sp & 255u) == 0u) { if (xb_ld(&bar[XB_TMO])) break; if (sp > XB_SPIN_CAP) { atomicAdd(&bar[XB_TMO], 1u); break; } }
    }
    nloc = mine > 0u ? mine : 1u; nx = cnt > 0u ? cnt : 1u;
}

__device__ __forceinline__ void xcd_barrier(const XcdBarrier& b) {
    asm volatile("s_waitcnt vmcnt(0)" ::: "memory");
    __syncthreads();
    if (threadIdx.x == 0) {
        unsigned* bar = b.bar;
        __builtin_amdgcn_s_waitcnt(0);
        unsigned nloc = b.st[0], nx = b.st[1];
        if (nloc == 0u) { xcd_barrier_complete(bar, b.x, nloc, nx); b.st[0] = nloc; b.st[1] = nx; }
        const unsigned old = xb_add(&bar[XB_XSUB(b.x)], 1u);
        const unsigned gen = old / nloc;
        if (old + 1u == (gen + 1u) * nloc) {
            __builtin_amdgcn_fence(__ATOMIC_RELEASE, "agent");
            asm volatile("s_waitcnt vmcnt(0)" ::: "memory");
            const unsigned og = xb_add(&bar[XB_TOP], 1u);
            const unsigned tg = og / nx;
            if (og + 1u == (tg + 1u) * nx) xb_add(&bar[XB_TOPGEN], 1u);
            else XB_SPIN(xb_ld(&bar[XB_TOPGEN]) == tg, bar);
            __builtin_amdgcn_fence(__ATOMIC_ACQUIRE, "agent");
            xb_add(&bar[XB_XGEN(b.x)], 1u);
            asm volatile("s_waitcnt vmcnt(0)" ::: "memory");
        } else {
            XB_SPIN(xb_ld(&bar[XB_XGEN(b.x)]) == gen, bar);
            __builtin_amdgcn_fence(__ATOMIC_ACQUIRE, "agent");
            asm volatile("s_waitcnt vmcnt(0)" ::: "memory");
        }
    }
    __syncthreads();
}

struct Args { const float* in[22]; float* out; unsigned char* ws; int ph_lo, ph_hi, li, norope; };
enum { I_X = 0, I_C, I_WADA, I_BADA, I_F1PRE, I_F1POST, I_F1G, I_F1U, I_F1D, I_MPRE, I_MPOST, I_WIN, I_CONVW, I_ALOG, I_DTB, I_GNORM, I_WOUT, I_F2PRE, I_F2POST, I_F2G, I_F2U, I_F2D };

struct TItem { const float* src; bf16* dst; int ldw, K, nvalid; };
__device__ __forceinline__ void titem_load(const TItem& t, f32x4 (&v)[16], int lane) {
    const int r4 = lane >> 4, c4 = lane & 15;
    const GAS f32x4* p = (const GAS f32x4*)(t.src + (size_t)r4 * t.ldw + 4 * c4); const size_t st = (size_t)t.ldw;
#pragma unroll
    for (int i = 0; i < 16; ++i) v[i] = p[i * st];
}
__device__ __forceinline__ void titem_store(const TItem& t, const f32x4 (&v)[16], LAS float* scr, int lane) {
    const int r4 = lane >> 4, c4 = lane & 15; const bool ok = 4 * c4 < t.nvalid;
#pragma unroll
    for (int i = 0; i < 16; ++i) { LAS float* d = scr + (4 * i + r4) * 65 + 4 * c4; const f32x4 x = ok ? v[i] : (f32x4){0.f, 0.f, 0.f, 0.f}; d[0] = x.x; d[1] = x.y; d[2] = x.z; d[3] = x.w; }
    LDS_WAIT(); asm volatile("" ::: "memory");
#pragma unroll
    for (int j = 0; j < 8; ++j) { const int q = lane + 64 * j, nn = q >> 3, c = q & 7; const LAS float* s = scr + (8 * c) * 65 + nn;
        v4u o; o.x = pk2(s[0 * 65], s[1 * 65]); o.y = pk2(s[2 * 65], s[3 * 65]); o.z = pk2(s[4 * 65], s[5 * 65]); o.w = pk2(s[6 * 65], s[7 * 65]);
        *(GAS v4u*)(t.dst + (size_t)nn * t.K + 8 * c) = o; }
    LDS_WAIT(); asm volatile("" ::: "memory");
}
constexpr int CI_GU = (DM / 64) * (DFF / 64), CI_DN = (DFF / 64) * (DM / 64), CI_INA = (DM / 64) * (4096 / 64), CI_INB = (DM / 64) * (3072 / 64), CI_INP = (DM / 64) * (256 / 64), CI_OUT = (DM / 64) * (DM / 64);
constexpr int VI_F1 = 0, VI_IN = VI_F1 + 2 * CI_GU + CI_DN, VI_OUT = VI_IN + CI_INA + CI_INB + CI_INP, VI_F2GU = VI_OUT + CI_OUT, VI_F2D = VI_F2GU + 2 * CI_GU, VI_END = VI_F2D + CI_DN;
__device__ __forceinline__ TItem titem_decode(const Args& A, int vi) {
    unsigned char* ws = A.ws; int r = vi; TItem t;
#define TI_SET(Wp, ldw_, scol_, nv_, K_, WTp, drow_, k0_) do { t.src = (Wp) + (size_t)(k0_) * (ldw_) + (scol_); t.dst = (WTp) + (size_t)(drow_) * (K_) + (k0_); t.ldw = (ldw_); t.K = (K_); t.nvalid = (nv_); return t; } while (0)
#define TR_GU(Wp, WTp, add) if (r < CI_GU) { const int kb = r / (DFF / 64), n0 = (r % (DFF / 64)) * 64; TI_SET(Wp, DFF, n0, 64, DM, WTp, 256 * (n0 >> 7) + (n0 & 127) + (add), kb * 64); } r -= CI_GU;
#define TR_DN(Wp, WTp) if (r < CI_DN) { const int kb = r / (DM / 64), n0 = (r % (DM / 64)) * 64; TI_SET(Wp, DM, n0, 64, DFF, WTp, n0, kb * 64); } r -= CI_DN;
    TR_GU(A.in[I_F1G], (bf16*)(ws + WS_WGU1), 0)
    TR_GU(A.in[I_F1U], (bf16*)(ws + WS_WGU1), 128)
    TR_DN(A.in[I_F1D], (bf16*)(ws + WS_WD1))
    bf16* WIN = (bf16*)(ws + WS_WIN);
    if (r < CI_INA) { const int kb = r / 64, n0 = (r % 64) * 64; TI_SET(A.in[I_WIN], INC, n0, 64, DM, WIN, n0, kb * 64); } r -= CI_INA;
    if (r < CI_INB) { const int kb = r / 48, n0 = (r % 48) * 64; TI_SET(A.in[I_WIN], INC, 4112 + n0, 64, DM, WIN, 4096 + n0, kb * 64); } r -= CI_INB;
    if (r < CI_INP) { const int kb = r / 4, n0 = (r % 4) * 64; TI_SET(A.in[I_WIN], INC, 4096, n0 == 0 ? 16 : 0, DM, WIN, 7168 + n0, kb * 64); } r -= CI_INP;
    if (r < CI_OUT) { const int kb = r / 32, n0 = (r % 32) * 64; TI_SET(A.in[I_WOUT], DM, n0, 64, DM, (bf16*)(ws + WS_WOUT), n0, kb * 64); } r -= CI_OUT;
    TR_GU(A.in[I_F2G], (bf16*)(ws + WS_WGU2), 0)
    TR_GU(A.in[I_F2U], (bf16*)(ws + WS_WGU2), 128)
    { const int kb = r / (DM / 64), n0 = (r % (DM / 64)) * 64; TI_SET(A.in[I_F2D], DM, n0, 64, DFF, (bf16*)(ws + WS_WD2), n0, kb * 64); }
#undef TR_GU
#undef TR_DN
#undef TI_SET
}
__device__ __forceinline__ void conv_stream(const Args& A, int first, int last, int step, LAS float* scr, int lane) {
    for (int it = first; it < last; it += step) { const TItem t = titem_decode(A, it); f32x4 v[16]; titem_load(t, v, lane); titem_store(t, v, scr, lane); }
}
__device__ __forceinline__ void adaln_item(const Args& A, int item, LAS unsigned char* lds, int tid, int lane, int wave) {
    const float* c = A.in[I_C]; const float* w_ada = A.in[I_WADA]; float* mod = (float*)(A.ws + WS_MOD);
    LAS float* sl = (LAS float*)lds;
    LAS float* red = (LAS float*)(lds + 32768);
    __syncthreads();
    for (int i = tid; i < NB * DM; i += NTHR) { const int b = i >> 11, k = i & 2047; sl[k * 4 + b] = silu_acc(c[i]); }
    __syncthreads();
    f32x2 a0 = {0.f, 0.f}, a1 = a0, a2 = a0, a3 = a0;
    const GAS f32x2* wp = (const GAS f32x2*)(w_ada + (size_t)(wave * 256) * NMODC + item * 128) + lane;
    const LAS f32x4* sp = (const LAS f32x4*)sl + wave * 256;
#pragma unroll 16
    for (int kk = 0; kk < 256; ++kk) { const f32x2 w = wp[(size_t)kk * (NMODC / 2)]; const f32x4 s = sp[kk]; a0 += s.x * w; a1 += s.y * w; a2 += s.z * w; a3 += s.w * w; }
    red[(wave * 4 + 0) * 128 + 2 * lane] = a0.x; red[(wave * 4 + 0) * 128 + 2 * lane + 1] = a0.y;
    red[(wave * 4 + 1) * 128 + 2 * lane] = a1.x; red[(wave * 4 + 1) * 128 + 2 * lane + 1] = a1.y;
    red[(wave * 4 + 2) * 128 + 2 * lane] = a2.x; red[(wave * 4 + 2) * 128 + 2 * lane + 1] = a2.y;
    red[(wave * 4 + 3) * 128 + 2 * lane] = a3.x; red[(wave * 4 + 3) * 128 + 2 * lane + 1] = a3.y;
    __syncthreads();
    { const int b = tid >> 7, col = tid & 127; float s = A.in[I_BADA][item * 128 + col];
#pragma unroll
      for (int w = 0; w < 8; ++w) s += red[(w * 4 + b) * 128 + col];
      mod[b * NMODC + item * 128 + col] = s; }
    __syncthreads();
}
__device__ __forceinline__ void adaln_wait(const Args& A, unsigned need, int tid) {
    if (tid == 0) { unsigned sp = 0; while (__hip_atomic_load((unsigned*)(A.ws + WS_CTL) + CW_ADA, __ATOMIC_RELAXED, __HIP_MEMORY_SCOPE_AGENT) < need) { __builtin_amdgcn_s_sleep(4); if (++sp > (1u << 22)) break; }
        __builtin_amdgcn_fence(__ATOMIC_ACQUIRE, "agent"); asm volatile("s_waitcnt vmcnt(0)" ::: "memory"); }
    __syncthreads();
}
__device__ __forceinline__ void adaln_p0_item(const Args& A, int item, LAS unsigned char* lds, int tid, int lane, int wave) {
    const float* c = A.in[I_C]; const float* w_ada = A.in[I_WADA]; float* part = (float*)(A.ws + WS_APART);
    const int cc = item >> 2, kq = item & 3;
    LAS float* sl = (LAS float*)lds;
    LAS float* red = (LAS float*)(lds + 32768);
    __syncthreads();
    for (int i = tid; i < NB * 512; i += NTHR) { const int b = i >> 9, k = i & 511; sl[k * 4 + b] = silu_acc(c[b * DM + 512 * kq + k]); }
    __syncthreads();
    f32x2 a0 = {0.f, 0.f}, a1 = a0, a2 = a0, a3 = a0;
    const GAS f32x2* wp = (const GAS f32x2*)(w_ada + (size_t)(512 * kq + wave * 64) * NMODC + cc * 128) + lane;
    const LAS f32x4* sp = (const LAS f32x4*)sl + wave * 64;
#pragma unroll 16
    for (int kk = 0; kk < 64; ++kk) { const f32x2 w = wp[(size_t)kk * (NMODC / 2)]; const f32x4 s = sp[kk]; a0 += s.x * w; a1 += s.y * w; a2 += s.z * w; a3 += s.w * w; }
    red[(wave * 4 + 0) * 128 + 2 * lane] = a0.x; red[(wave * 4 + 0) * 128 + 2 * lane + 1] = a0.y;
    red[(wave * 4 + 1) * 128 + 2 * lane] = a1.x; red[(wave * 4 + 1) * 128 + 2 * lane + 1] = a1.y;
    red[(wave * 4 + 2) * 128 + 2 * lane] = a2.x; red[(wave * 4 + 2) * 128 + 2 * lane + 1] = a2.y;
    red[(wave * 4 + 3) * 128 + 2 * lane] = a3.x; red[(wave * 4 + 3) * 128 + 2 * lane + 1] = a3.y;
    __syncthreads();
    { const int b = tid >> 7, col = tid & 127; float s = (kq == 0) ? A.in[I_BADA][cc * 128 + col] : 0.f;
#pragma unroll
      for (int w = 0; w < 8; ++w) s += red[(w * 4 + b) * 128 + col];
      __hip_atomic_store(part + (size_t)(kq * NB + b) * 4096 + cc * 128 + col, s, __ATOMIC_RELAXED, __HIP_MEMORY_SCOPE_AGENT); }
    asm volatile("s_waitcnt vmcnt(0)" ::: "memory"); __syncthreads();
    if (tid == 0) __hip_atomic_fetch_add((unsigned*)(A.ws + WS_CTL) + CW_ADA, 1u, __ATOMIC_RELAXED, __HIP_MEMORY_SCOPE_AGENT);
    __syncthreads();
}
__device__ __forceinline__ void fill_slot(const Args& A, LAS unsigned char* lds, int tid, int lane, int wave, int sb, int nb, int a0, int nada, int vlo, int vhi, int c1) {
    if (sb < nada) { if (a0 < 0) adaln_p0_item(A, sb, lds, tid, lane, wave); else adaln_item(A, a0 + sb, lds, tid, lane, wave); }
    LAS float* scr = (LAS float*)(lds + wave * 16640);
    const int sw = sb * NWAVES + wave, nwa = nb * NWAVES, nwl = nada * NWAVES;
    conv_stream(A, vlo + sw, vlo + c1, nwa, scr, lane);
    if (sb >= nada) conv_stream(A, vlo + c1 + (sw - nwl), vhi, nwa - nwl, scr, lane);
}
__device__ __forceinline__ void rope_table(const Args& A, int tid) {
    const int e = (int)blockIdx.x * NTHR + tid;
    if (e < SEQ * 16) { const int pos = e >> 4, i = e & 15;
        const float invf = (float)exp2(-(double)i * (18.931568569324174 / 16.0));
        const float ang = (float)pos * invf; const double ad = (double)ang;
        const double q = rint(ad * 0.63661977236758134308); const double r = ad - q * 1.57079632679489661923; const double r2 = r * r;
        const double sr = r * (1.0 + r2 * (-1.0 / 6 + r2 * (1.0 / 120 + r2 * (-1.0 / 5040 + r2 * (1.0 / 362880 + r2 * (-1.0 / 39916800 + r2 * (1.0 / 6227020800.0)))))));
        const double cr = 1.0 + r2 * (-0.5 + r2 * (1.0 / 24 + r2 * (-1.0 / 720 + r2 * (1.0 / 40320 + r2 * (-1.0 / 3628800 + r2 * (1.0 / 479001600.0))))));
        const int qi = ((int)q) & 3; double sv, cv;
        if (qi == 0) { sv = sr; cv = cr; } else if (qi == 1) { sv = cr; cv = -sr; } else if (qi == 2) { sv = -sr; cv = -cr; } else { sv = -cr; cv = sr; }
        ((f32x2*)(A.ws + WS_ROPE))[e] = (f32x2){(float)cv, (float)sv}; }
}

template <int MODE>
__device__ __forceinline__ void row_pass(const float* xr, const float* Y, float* xo, bf16* H, const float* mod, const float* post_g, int i_ga, float gscale, const float* pre_g, int i_sh, int i_sc, int gw, int NGW, int lane) {
    for (int row = gw; row < M; row += NGW) {
        const int b = row >> 11;
        const GAS f32x4* xp = (const GAS f32x4*)(xr + (size_t)row * DM) + lane;
        f32x4 x[8];
#pragma unroll
        for (int j = 0; j < 8; ++j) x[j] = xp[64 * j];
        if (MODE != 0) {
            const GAS f32x4* yp = (const GAS f32x4*)(Y + (size_t)row * DM) + lane;
            f32x4 y[8]; float ss = 0.f;
#pragma unroll
            for (int j = 0; j < 8; ++j) { y[j] = yp[64 * j]; ss += (y[j].x * y[j].x + y[j].y * y[j].y) + (y[j].z * y[j].z + y[j].w * y[j].w); }
            const float rstd = 1.0f / sqrtf(wave_sum(ss) * (1.0f / DM) + EPS);
            const GAS f32x4* gp = (const GAS f32x4*)post_g + lane; const GAS f32x4* gap = (const GAS f32x4*)(mod + (size_t)b * NMODC + i_ga * DM) + lane;
            GAS f32x4* op = (GAS f32x4*)(xo + (size_t)row * DM) + lane;
#pragma unroll
            for (int j = 0; j < 8; ++j) { const f32x4 g = gp[64 * j], ga = gap[64 * j]; x[j] = x[j] + (gscale * ga) * ((y[j] * rstd) * g); op[64 * j] = x[j]; }
        }
        if (MODE != 2) {
            float ss = 0.f;
#pragma unroll
            for (int j = 0; j < 8; ++j) ss += (x[j].x * x[j].x + x[j].y * x[j].y) + (x[j].z * x[j].z + x[j].w * x[j].w);
            const float rstd = 1.0f / sqrtf(wave_sum(ss) * (1.0f / DM) + EPS);
            const GAS f32x4* gp = (const GAS f32x4*)pre_g + lane; const GAS f32x4* scp = (const GAS f32x4*)(mod + (size_t)b * (MODE == 0 ? 4096 : NMODC) + i_sc * DM) + lane; const GAS f32x4* shp = (const GAS f32x4*)(mod + (size_t)b * (MODE == 0 ? 4096 : NMODC) + i_sh * DM) + lane;
            GAS v2u* hp = (GAS v2u*)(H + (size_t)row * DM) + lane;
#pragma unroll
            for (int j = 0; j < 8; ++j) { const f32x4 g = gp[64 * j]; f32x4 sc = scp[64 * j], sh = shp[64 * j];
                if (MODE == 0) { sc = (sc + scp[64 * j + NB * 1024]) + (scp[64 * j + 2 * NB * 1024] + scp[64 * j + 3 * NB * 1024]); sh = (sh + shp[64 * j + NB * 1024]) + (shp[64 * j + 2 * NB * 1024] + shp[64 * j + 3 * NB * 1024]); }
                const f32x4 h = ((x[j] * rstd) * g) * (1.0f + sc) + sh;
                v2u o; o.x = pk2(h.x, h.y); o.y = pk2(h.z, h.w); hp[64 * j] = o; }
        }
    }
}

__device__ __forceinline__ void row_pass_first(const Args& A, LAS unsigned char* lds, bf16* H, int gw, int NGW, int tid, int lane) {
    const float* part = (const float*)(A.ws + WS_APART); const float* xr = A.in[I_X]; const float* pre_g = A.in[I_F1PRE];
    LAS f32x4* Am = (LAS f32x4*)lds; LAS f32x4* Bm = (LAS f32x4*)(lds + 32768);
#pragma unroll
    for (int i = 0; i < 4; ++i) { const int p = tid + NTHR * i, b = p >> 9, c4 = p & 511;
        const GAS f32x4* ps = (const GAS f32x4*)(part + (size_t)b * 4096) + c4; f32x4 sh = ps[0], sc = ps[512];
#pragma unroll
        for (int kq = 1; kq < 4; ++kq) { sh += ps[(size_t)kq * NB * 1024]; sc += ps[(size_t)kq * NB * 1024 + 512]; }
        const f32x4 g = ((const GAS f32x4*)pre_g)[c4]; Am[p] = g * (1.0f + sc); Bm[p] = sh; }
    __syncthreads();
    if (M == 4 * NGW) {
        f32x4 x[4][8];
#pragma unroll
        for (int i = 0; i < 4; ++i) { const GAS f32x4* xp = (const GAS f32x4*)(xr + (size_t)(gw + i * NGW) * DM) + lane;
#pragma unroll
            for (int j = 0; j < 8; ++j) x[i][j] = xp[64 * j]; }
#pragma unroll
        for (int i = 0; i < 4; ++i) { const int row = gw + i * NGW, b = row >> 11; float ss = 0.f;
#pragma unroll
            for (int j = 0; j < 8; ++j) ss += (x[i][j].x * x[i][j].x + x[i][j].y * x[i][j].y) + (x[i][j].z * x[i][j].z + x[i][j].w * x[i][j].w);
            const float rstd = 1.0f / sqrtf(wave_sum(ss) * (1.0f / DM) + EPS);
            GAS v2u* hp = (GAS v2u*)(H + (size_t)row * DM) + lane;
#pragma unroll
            for (int j = 0; j < 8; ++j) { const f32x4 h = (x[i][j] * rstd) * Am[b * 512 + lane + 64 * j] + Bm[b * 512 + lane + 64 * j]; v2u o; o.x = pk2(h.x, h.y); o.y = pk2(h.z, h.w); hp[64 * j] = o; } }
    } else {
        for (int row = gw; row < M; row += NGW) { const int b = row >> 11; const GAS f32x4* xp = (const GAS f32x4*)(xr + (size_t)row * DM) + lane; f32x4 x[8]; float ss = 0.f;
#pragma unroll
            for (int j = 0; j < 8; ++j) { x[j] = xp[64 * j]; ss += (x[j].x * x[j].x + x[j].y * x[j].y) + (x[j].z * x[j].z + x[j].w * x[j].w); }
            const float rstd = 1.0f / sqrtf(wave_sum(ss) * (1.0f / DM) + EPS); GAS v2u* hp = (GAS v2u*)(H + (size_t)row * DM) + lane;
#pragma unroll
            for (int j = 0; j < 8; ++j) { const f32x4 h = (x[j] * rstd) * Am[b * 512 + lane + 64 * j] + Bm[b * 512 + lane + 64 * j]; v2u o; o.x = pk2(h.x, h.y); o.y = pk2(h.z, h.w); hp[64 * j] = o; } }
    }
}
__device__ __forceinline__ void rope_q_phase(const Args& A, int gw, int NGW, int lane) {
    unsigned char* ws = A.ws; bf16* PROJ = (bf16*)(ws + WS_PROJ); const f32x2* rope = (const f32x2*)(ws + WS_ROPE);
    for (int row = gw; row < M; row += NGW) {
        const int s = row & (SEQ - 1);
#pragma unroll
        for (int jj = 0; jj < 2; ++jj) { const int p = lane + 64 * jj, hh = (p >> 4) & 7, i = p & 15;
            bf16* c1 = PROJ + (size_t)row * NIN + PC_MQ + hh * 128 + i; const float x1 = bf2f(c1[0]), x2 = bf2f(c1[16]); const f32x2 cs = rope[s * 16 + i];
            c1[0] = (bf16)f2bf(x1 * cs.x - x2 * cs.y); c1[16] = (bf16)f2bf(x2 * cs.x + x1 * cs.y); }
    }
}
__device__ __forceinline__ void krope_kmean_item(const Args& A, int it, LAS unsigned char* lds, int tid) {
    bf16* PROJ = (bf16*)(A.ws + WS_PROJ); float* KM = (float*)(A.ws + WS_KMEAN); const f32x2* rope = (const f32x2*)(A.ws + WS_ROPE); LAS float* red = (LAS float*)lds;
    const int b = it >> 6, n = (it >> 3) & 7, h = it & 7; const int rg = tid >> 4, c8 = tid & 15;
    float sum[8];
#pragma unroll
    for (int e = 0; e < 8; ++e) sum[e] = 0.f;
    __syncthreads();
#pragma unroll
    for (int rr = 0; rr < 8; ++rr) { const int s = n * 256 + rg * 8 + rr; bf16* p = PROJ + (size_t)(b * SEQ + s) * NIN + PC_MK + h * 128 + 8 * c8;
        v4u v = *(const GAS v4u*)p; float f[8] = {bflo(v.x), bfhi(v.x), bflo(v.y), bfhi(v.y), bflo(v.z), bfhi(v.z), bflo(v.w), bfhi(v.w)};
        const unsigned px = __shfl_xor(v.x, 2), py = __shfl_xor(v.y, 2), pz = __shfl_xor(v.z, 2), pw = __shfl_xor(v.w, 2);
        if (c8 < 4) { const float g[8] = {bflo(px), bfhi(px), bflo(py), bfhi(py), bflo(pz), bfhi(pz), bflo(pw), bfhi(pw)};
#pragma unroll
            for (int e = 0; e < 8; ++e) { const f32x2 cs = rope[s * 16 + (c8 & 1) * 8 + e]; f[e] = (c8 < 2) ? f[e] * cs.x - g[e] * cs.y : f[e] * cs.x + g[e] * cs.y; }
            v.x = pk2(f[0], f[1]); v.y = pk2(f[2], f[3]); v.z = pk2(f[4], f[5]); v.w = pk2(f[6], f[7]); *(GAS v4u*)p = v;
            f[0] = bflo(v.x); f[1] = bfhi(v.x); f[2] = bflo(v.y); f[3] = bfhi(v.y); f[4] = bflo(v.z); f[5] = bfhi(v.z); f[6] = bflo(v.w); f[7] = bfhi(v.w); }
#pragma unroll
        for (int e = 0; e < 8; ++e) sum[e] += f[e]; }
#pragma unroll
    for (int e = 0; e < 8; ++e) red[rg * 128 + 8 * c8 + e] = sum[e];
    __syncthreads();
    if (tid < 128) { float s = 0.f;
#pragma unroll
        for (int g = 0; g < 32; ++g) s += red[g * 128 + tid];
        KM[((b * 8 + h) * 8 + n) * 128 + tid] = s * (1.0f / 256.0f); }
}
namespace gdn {
typedef float f32x16 __attribute__((ext_vector_type(16)));
constexpr int OPS_BYTES = 57344, WF_OFF = 0, QGF_OFF = 16384, KDF_OFF = 32768, AF_OFF = 49152;
constexpr int UF_BYTES = 32768, GZ_BYTES = 16384;
constexpr int IMG_ST = 136;
constexpr int L_KS = 0, L_VS = 32768, L_X = 65536, L_KHI = L_X, L_KLO = L_X + 17408, L_QHI = L_X + 34816, L_LM = L_X, L_AM = L_X + 16384, L_WB = L_QHI, L_SM = L_X + 52224;
__device__ __forceinline__ int crow(int r, int hi) { return (r & 3) + 8 * (r >> 2) + 4 * hi; }
__device__ __forceinline__ unsigned pkbf(float lo, float hi) { return pk2(lo, hi); }

__device__ __forceinline__ void st16wt(GAS void* p, v4u v) { asm volatile("global_store_dwordx4 %0, %1, off sc1\n\ts_nop 1" :: "v"(p), "v"(v)); }
__device__ __forceinline__ void prep_wait(const Args& A, int c0, int cnt, int lane) {
    gu32* pc = (gu32*)(A.ws + WS_CTL) + CW_PREP; unsigned sp = 0;
    for (;;) { unsigned v = 32u; if (lane < cnt) v = __hip_atomic_load(pc + 16 * (c0 + lane), __ATOMIC_RELAXED, __HIP_MEMORY_SCOPE_AGENT);
        if (__all(v >= 32u)) break; __builtin_amdgcn_s_sleep(8); if (++sp > (1u << 20)) break; }
    __builtin_amdgcn_fence(__ATOMIC_ACQUIRE, "agent"); asm volatile("s_waitcnt vmcnt(0)" ::: "memory");
}
#define LDS_BAR() do { asm volatile("s_waitcnt lgkmcnt(0)" ::: "memory"); __builtin_amdgcn_s_barrier(); asm volatile("" ::: "memory"); } while (0)
constexpr int C32_UP = (DM / 64) * (DFF / 32), C32_OUT = (DM / 64) * (DM / 32), C32_ALL = C32_UP + C32_OUT, L_C32 = 118784;
__device__ __forceinline__ void conv32_item(const Args& A, int j, LAS float* scr, int lane) {
    const float* src; bf16* dst; int ldw;
    if (j < C32_UP) { const int kb = j / (DFF / 32), n0 = (j % (DFF / 32)) * 32; src = A.in[I_F2U] + (size_t)(kb * 64) * DFF + n0; dst = (bf16*)(A.ws + WS_WGU2) + (size_t)(256 * (n0 >> 7) + (n0 & 127) + 128) * DM + kb * 64; ldw = DFF; }
    else { const int jj = j - C32_UP, kb = jj / (DM / 32), n0 = (jj % (DM / 32)) * 32; src = A.in[I_WOUT] + (size_t)(kb * 64) * DM + n0; dst = (bf16*)(A.ws + WS_WOUT) + (size_t)n0 * DM + kb * 64; ldw = DM; }
    const int r8 = lane >> 3, c4 = lane & 7; const GAS f32x4* p = (const GAS f32x4*)(src + (size_t)r8 * ldw + 4 * c4); f32x4 v[8];
#pragma unroll
    for (int i = 0; i < 8; ++i) v[i] = p[(size_t)i * 2 * ldw];
#pragma unroll
    for (int i = 0; i < 8; ++i) { LAS float* d = scr + (8 * i + r8) * 33 + 4 * c4; d[0] = v[i].x; d[1] = v[i].y; d[2] = v[i].z; d[3] = v[i].w; }
    LDS_WAIT(); asm volatile("" ::: "memory");
#pragma unroll
    for (int jq = 0; jq < 4; ++jq) { const int q = lane + 64 * jq, nn = q >> 3, c = q & 7; const LAS float* s = scr + (8 * c) * 33 + nn;
        v4u o; o.x = pk2(s[0 * 33], s[1 * 33]); o.y = pk2(s[2 * 33], s[3 * 33]); o.z = pk2(s[4 * 33], s[5 * 33]); o.w = pk2(s[6 * 33], s[7 * 33]);
        *(GAS v4u*)(dst + (size_t)nn * DM + 8 * c) = o; }
    LDS_WAIT(); asm volatile("" ::: "memory");
}

__device__ __forceinline__ void prep_touch(const Args& A, int item, int th) {
    const int b = item >> 8, h = (item >> 5) & 7, n = item & 31; const int t0 = b * SEQ + n * 64, s0 = n * 64; const bf16* PROJ = (const bf16*)(A.ws + WS_PROJ);
    unsigned sink = 0u;
#pragma unroll
    for (int i = 0; i < 2; ++i) { const int idx = th + 256 * i, row = idx / 6, l6 = idx % 6;
        if (row < 67 && s0 + row - 3 >= 0) sink ^= *(const GAS unsigned*)(PROJ + (size_t)(t0 + row - 3) * NIN + (l6 >> 1) * 1024 + h * 128 + (l6 & 1) * 64); }
    if (th < 128) sink ^= *(const GAS unsigned*)(PROJ + (size_t)(t0 + (th >> 1)) * NIN + PC_GZ + h * 128 + (th & 1) * 64);
    else if (th < 192) sink ^= *(const GAS unsigned*)(PROJ + (size_t)(t0 + th - 128) * NIN + PC_A);
    asm volatile("" :: "v"(sink));
}
__device__ __forceinline__ void prep_item(const Args& A, int item, int nxt, int pub, int cidx, LAS unsigned char* lds, int tid, int lane, int wave) {
    asm volatile("" : "+v"(tid), "+v"(lane));
    const int b = item >> 8, h = (item >> 5) & 7, n = item & 31; const int t0 = b * SEQ + n * 64, s0 = n * 64;
    unsigned char* ws = A.ws; const bf16* PROJ = (const bf16*)(ws + WS_PROJ);
    unsigned char* ops = ws + WS_OPS + (size_t)item * OPS_BYTES; float* UF = (float*)(ws + WS_UF + (size_t)item * UF_BYTES); bf16* GZ = (bf16*)(ws + WS_GZ + (size_t)item * GZ_BYTES);
    LAS float* ks = (LAS float*)(lds + L_KS); LAS float* vs = (LAS float*)(lds + L_VS);
    LAS bf16* khi = (LAS bf16*)(lds + L_KHI); LAS bf16* klo = (LAS bf16*)(lds + L_KLO); LAS bf16* qhi = (LAS bf16*)(lds + L_QHI);
    LAS float* Lm = (LAS float*)(lds + L_LM); LAS float* Am = (LAS float*)(lds + L_AM); LAS bf16* Wb = (LAS bf16*)(lds + L_WB);
    LAS float* Gs = (LAS float*)(lds + L_SM); LAS float* bs = Gs + 64; LAS float* es = Gs + 128; LAS float* dsx = Gs + 192;
    LDS_BAR();
    if (wave == 6) {
        const float av = bf2f(PROJ[(size_t)(t0 + lane) * NIN + PC_A + h]), bv = bf2f(PROJ[(size_t)(t0 + lane) * NIN + PC_B + h]);
        const float xx = av + A.in[I_DTB][h]; const float sp = fmaxf(xx, 0.f) + log1pf(expf(-fabsf(xx)));
        float G = -expf(A.in[I_ALOG][h]) * sp;
#pragma unroll
        for (int o = 1; o < 64; o <<= 1) { const float t = __shfl_up(G, o); if (lane >= o) G += t; }
        const float Gl = __shfl(G, 63);
        Gs[lane] = G; bs[lane] = 1.0f / (1.0f + expf(-bv)); es[lane] = expf(G); dsx[lane] = expf(Gl - G);
        if (lane == 0) __hip_atomic_store((float*)(ws + WS_DEC) + item * 32, expf(Gl),     __ATOMIC_RELAXED, __HIP_MEMORY_SCOPE_AGENT);
    }
    v4u zpre[4] = {};
    if (wave >= 4) {
#pragma unroll
        for (int it = 0; it < 4; ++it) { const int e = (tid - 256) + 256 * it; zpre[it] = *(const GAS v4u*)(PROJ + (size_t)(t0 + (e >> 4)) * NIN + PC_GZ + h * 128 + 8 * (e & 15)); } }
    const int r = tid >> 3, cg = tid & 7;
    const int mat = wave >> 1, cgn = tid & 7, rg4 = (tid & 127) >> 3;
    float qv[4][16];
    if (wave < 6) {
        const int col = mat * 1024 + h * 128 + 16 * cgn;
        f32x4 wt[4][4];
#pragma unroll
        for (int jj = 0; jj < 4; ++jj) { const GAS f32x4* wp = (const GAS f32x4*)(A.in[I_CONVW] + jj * CONVC + col); wt[jj][0] = wp[0]; wt[jj][1] = wp[1]; wt[jj][2] = wp[2]; wt[jj][3] = wp[3]; }
        v4u in0[7], in1[7];
#pragma unroll
        for (int k = 0; k < 7; ++k) { const int row = 4 * rg4 - 3 + k; const bool okr = (s0 + row) >= 0;
            const GAS v4u* pp = (const GAS v4u*)(PROJ + (size_t)(okr ? t0 + row : t0) * NIN + col); const v4u a0 = pp[0], a1 = pp[1];
            in0[k] = okr ? a0 : (v4u){0u, 0u, 0u, 0u}; in1[k] = okr ? a1 : (v4u){0u, 0u, 0u, 0u}; }
#pragma unroll
        for (int rr = 0; rr < 4; ++rr) { const int row = 4 * rg4 + rr; float acc[16];
#pragma unroll
            for (int i = 0; i < 16; ++i) acc[i] = 0.f;
#pragma unroll
            for (int jj = 0; jj < 4; ++jj) { const v4u v0 = in0[rr + jj], v1 = in1[rr + jj]; const f32x4 w0 = wt[jj][0], w1 = wt[jj][1], w2 = wt[jj][2], w3 = wt[jj][3];
                acc[0] += w0.x * bflo(v0.x); acc[1] += w0.y * bfhi(v0.x); acc[2] += w0.z * bflo(v0.y); acc[3] += w0.w * bfhi(v0.y);
                acc[4] += w1.x * bflo(v0.z); acc[5] += w1.y * bfhi(v0.z); acc[6] += w1.z * bflo(v0.w); acc[7] += w1.w * bfhi(v0.w);
                acc[8] += w2.x * bflo(v1.x); acc[9] += w2.y * bfhi(v1.x); acc[10] += w2.z * bflo(v1.y); acc[11] += w2.w * bfhi(v1.y);
                acc[12] += w3.x * bflo(v1.z); acc[13] += w3.y * bfhi(v1.z); acc[14] += w3.z * bflo(v1.w); acc[15] += w3.w * bfhi(v1.w); }
            float ss = 0.f;
#pragma unroll
            for (int i = 0; i < 16; ++i) { acc[i] = silu_fast(acc[i]); ss += acc[i] * acc[i]; }
            if (mat < 2) { ss += __shfl_xor(ss, 1); ss += __shfl_xor(ss, 2); ss += __shfl_xor(ss, 4); const float rn = (1.0f / sqrtf(ss + EPS)) * (mat == 0 ? 0.08838834764831845f : 1.0f);
#pragma unroll
                for (int i = 0; i < 16; ++i) acc[i] *= rn; }
            if (mat == 0) {
#pragma unroll
                for (int i = 0; i < 16; ++i) qv[rr][i] = acc[i];
                unsigned w[8];
#pragma unroll
                for (int i = 0; i < 8; ++i) w[i] = pkbf(acc[2 * i], acc[2 * i + 1]);
                LAS v4u* dst = (LAS v4u*)(qhi + row * IMG_ST + 16 * cgn); dst[0] = (v4u){w[0], w[1], w[2], w[3]}; dst[1] = (v4u){w[4], w[5], w[6], w[7]};
            } else if (mat == 1) {
                LAS f32x4* kd = (LAS f32x4*)(ks + row * 128 + 16 * cgn);
#pragma unroll
                for (int i = 0; i < 4; ++i) kd[i] = (f32x4){acc[4 * i], acc[4 * i + 1], acc[4 * i + 2], acc[4 * i + 3]};
                unsigned wh[8], wl[8];
#pragma unroll
                for (int i = 0; i < 8; ++i) { const unsigned h0 = f2bf(acc[2 * i]), h1 = f2bf(acc[2 * i + 1]); wh[i] = h0 | (h1 << 16);
                    wl[i] = pkbf(acc[2 * i] - __builtin_bit_cast(float, h0 << 16), acc[2 * i + 1] - __builtin_bit_cast(float, h1 << 16)); }
                LAS v4u* dh = (LAS v4u*)(khi + row * IMG_ST + 16 * cgn); dh[0] = (v4u){wh[0], wh[1], wh[2], wh[3]}; dh[1] = (v4u){wh[4], wh[5], wh[6], wh[7]};
                LAS v4u* dl = (LAS v4u*)(klo + row * IMG_ST + 16 * cgn); dl[0] = (v4u){wl[0], wl[1], wl[2], wl[3]}; dl[1] = (v4u){wl[4], wl[5], wl[6], wl[7]};
            } else {
                LAS f32x4* vd = (LAS f32x4*)(vs + row * 128 + 16 * cgn);
#pragma unroll
                for (int i = 0; i < 4; ++i) vd[i] = (f32x4){acc[4 * i], acc[4 * i + 1], acc[4 * i + 2], acc[4 * i + 3]};
            }
        }
    }
    asm volatile("s_waitcnt vmcnt(0)" ::: "memory");
    LDS_BAR();
    if (pub >= 0 && tid == 7 * 64) __hip_atomic_fetch_add((gu32*)(ws + WS_CTL) + CW_PREP + 16 * pub, 1u, __ATOMIC_RELAXED, __HIP_MEMORY_SCOPE_AGENT);
    if (wave < 2) {
#pragma unroll
        for (int rr = 0; rr < 4; ++rr) { const int row = 4 * rg4 + rr; const float e = es[row]; unsigned w[8];
#pragma unroll
            for (int i = 0; i < 8; ++i) w[i] = pkbf(qv[rr][2 * i] * e, qv[rr][2 * i + 1] * e);
            unsigned char* dst = ops + QGF_OFF + ((((row >> 5) * 4 + (cgn >> 1)) * 2 + (cgn & 1)) * 64 + (row & 31)) * 16;
            st16wt((GAS void*)dst, (v4u){w[0], w[1], w[4], w[5]}); st16wt((GAS void*)(dst + 512), (v4u){w[2], w[3], w[6], w[7]}); } }
    f32x16 acc = {};
    const int job = wave % 3, mt = job == 0 ? 0 : 1, nt = job == 2 ? 1 : 0; const int r32 = lane & 31, hh = lane >> 5; const bool kkj = wave < 3;
    if (wave < 6) {
        const LAS bf16* Aimg = (wave < 3) ? khi : qhi;
#pragma unroll
        for (int ksx = 0; ksx < 8; ++ksx) {
            const bf16x8 a = *(const LAS bf16x8*)(Aimg + (32 * mt + r32) * IMG_ST + 16 * ksx + 8 * hh);
            const bf16x8 bh = *(const LAS bf16x8*)(khi + (32 * nt + r32) * IMG_ST + 16 * ksx + 8 * hh);
            acc = __builtin_amdgcn_mfma_f32_32x32x16_bf16(a, bh, acc, 0, 0, 0);
            if (wave < 3) {
                const bf16x8 al = *(const LAS bf16x8*)(klo + (32 * mt + r32) * IMG_ST + 16 * ksx + 8 * hh);
                const bf16x8 bl = *(const LAS bf16x8*)(klo + (32 * nt + r32) * IMG_ST + 16 * ksx + 8 * hh);
                acc = __builtin_amdgcn_mfma_f32_32x32x16_bf16(a, bl, acc, 0, 0, 0);
                acc = __builtin_amdgcn_mfma_f32_32x32x16_bf16(al, bh, acc, 0, 0, 0);
            }
        }
    }
    LDS_BAR();
    if (wave < 6) { const int j = 32 * nt + r32; const float Gj = Gs[j];
#pragma unroll
        for (int rg = 0; rg < 16; ++rg) { const int i = 32 * mt + crow(rg, hh); const float d = __builtin_amdgcn_exp2f((Gs[i] - Gj) * 1.4426950408889634f);
            if (kkj) Lm[i * 64 + j] = (j < i) ? bs[i] * acc[rg] * d : 0.f;
            else Am[i * 64 + j] = (j <= i) ? acc[rg] * d : 0.f; } }
    LDS_BAR();
    if (wave < 4) {
        float x[64]; const int c2 = tid; int lz; asm volatile("v_mov_b32 %0, 0" : "=v"(lz));
#pragma unroll
        for (int i = 0; i < 64; ++i) x[i] = bs[i + lz] * ((c2 < 128) ? vs[i * 128 + c2] : ks[i * 128 + (c2 - 128)] * es[i + lz]);
        f32x4 lc[16], ln[16];
#pragma unroll
        for (int j4 = 0; j4 < 16; ++j4) { lc[j4] = (f32x4){0.f, 0.f, 0.f, 0.f}; ln[j4] = lc[j4]; }
        lc[0] = *(const LAS f32x4*)(Lm + 64 + lz);
#pragma unroll
        for (int i = 1; i < 64; ++i) {
            if (i + 1 < 64) {
#pragma unroll
                for (int j4 = 0; j4 < (i + 4) / 4; ++j4) ln[j4] = *(const LAS f32x4*)(Lm + (i + 1) * 64 + 4 * j4 + lz); }
            __builtin_amdgcn_sched_barrier(0);
            f32x2 a0 = {0.f, 0.f}, a1 = {0.f, 0.f};
#pragma unroll
            for (int j4 = 0; j4 < (i + 3) / 4; ++j4) { const f32x4 l = lc[j4];
                a0 += (f32x2){l.x, l.y} * (f32x2){x[4 * j4], x[4 * j4 + 1]}; a1 += (f32x2){l.z, l.w} * (f32x2){x[4 * j4 + 2], x[4 * j4 + 3]}; }
            x[i] -= (a0.x + a0.y) + (a1.x + a1.y);
            __builtin_amdgcn_sched_barrier(0);
#pragma unroll
            for (int j4 = 0; j4 < 16; ++j4) lc[j4] = ln[j4];
        }
        if (c2 < 128) { const int w = c2 >> 5, c = c2 & 31;
#pragma unroll
            for (int m2 = 0; m2 < 2; ++m2)
#pragma unroll
                for (int rq = 0; rq < 4; ++rq)
#pragma unroll
                    for (int hi = 0; hi < 2; ++hi) { const int tb = 32 * m2 + 8 * rq + 4 * hi;
                        st16wt((GAS void*)(UF + ((((w * 2 + m2) * 4 + rq) * 64 + c + 32 * hi) * 4)), __builtin_bit_cast(v4u, (f32x4){x[tb], x[tb + 1], x[tb + 2], x[tb + 3]})); }
        } else { const int dk = c2 - 128;
#pragma unroll
            for (int i = 0; i < 64; ++i) Wb[i * 128 + dk] = (bf16)f2bf(-x[i]); }
    } else {
        const int ht = tid - 256;
#pragma unroll
        for (int it = 0; it < 2; ++it) { const int e = ht + 256 * it, c = e & 127, tg = e >> 7; float kv[16];
#pragma unroll
            for (int xk = 0; xk < 16; ++xk) kv[xk] = ks[(16 * tg + xk) * 128 + c] * dsx[16 * tg + xk];
            unsigned char* dst = ops + KDF_OFF + ((((c >> 5) * 2 + (tg >> 1)) * 2 + (tg & 1)) * 64 + (c & 31)) * 16;
            st16wt((GAS void*)dst, (v4u){pkbf(kv[0], kv[1]), pkbf(kv[2], kv[3]), pkbf(kv[8], kv[9]), pkbf(kv[10], kv[11])});
            st16wt((GAS void*)(dst + 512), (v4u){pkbf(kv[4], kv[5]), pkbf(kv[6], kv[7]), pkbf(kv[12], kv[13]), pkbf(kv[14], kv[15])}); }
#pragma unroll
        for (int it = 0; it < 2; ++it) { const int e = ht + 256 * it, ln = e & 63, f = e >> 6, s = f & 1, kb = (f >> 1) & 1, m2 = f >> 2; v4u o = {0u, 0u, 0u, 0u};
            if (!(m2 == 0 && kb == 1)) { const LAS float* ap = Am + (32 * m2 + (ln & 31)) * 64 + 32 * kb + 16 * s + 4 * (ln >> 5); const f32x4 a0 = *(const LAS f32x4*)ap, a1 = *(const LAS f32x4*)(ap + 8);
                o = (v4u){pkbf(a0.x, a0.y), pkbf(a0.z, a0.w), pkbf(a1.x, a1.y), pkbf(a1.z, a1.w)}; }
            st16wt((GAS void*)(ops + AF_OFF + e * 16), o); }
#pragma unroll
        for (int it = 0; it < 4; ++it) { const int e = ht + 256 * it, tok = e >> 4, c8 = e & 15;
            const v4u z = zpre[it]; const f32x4 g0 = *(const GAS f32x4*)(A.in[I_GNORM] + 8 * c8), g1 = *(const GAS f32x4*)(A.in[I_GNORM] + 8 * c8 + 4);
            v4u o; o.x = pkbf(silu_fast(bflo(z.x)) * g0.x, silu_fast(bfhi(z.x)) * g0.y); o.y = pkbf(silu_fast(bflo(z.y)) * g0.z, silu_fast(bfhi(z.y)) * g0.w);
            o.z = pkbf(silu_fast(bflo(z.z)) * g1.x, silu_fast(bfhi(z.z)) * g1.y); o.w = pkbf(silu_fast(bflo(z.w)) * g1.z, silu_fast(bfhi(z.w)) * g1.w);
            st16wt((GAS void*)(GZ + tok * 128 + 8 * c8), o); }
        if (nxt >= 0) prep_touch(A, nxt, ht);
        { LAS float* scr = (LAS float*)(lds + L_C32 + (wave - 4) * 8448);
#pragma unroll 1
          for (int jc = 0; jc < 2; ++jc) { const int ci = (cidx * 4 + (wave - 4)) * 2 + jc; if (ci < C32_ALL) conv32_item(A, ci, scr, lane); } }
    }
    LDS_BAR();
    { const LAS v4u* src = (const LAS v4u*)(Wb + r * 128 + 16 * cg); const v4u a = src[0], c = src[1];
      unsigned char* dst = ops + WF_OFF + ((((r >> 5) * 4 + (cg >> 1)) * 2 + (cg & 1)) * 64 + (r & 31)) * 16;
      st16wt((GAS void*)dst, (v4u){a.x, a.y, c.x, c.y}); st16wt((GAS void*)(dst + 512), (v4u){a.z, a.w, c.z, c.w}); }
}

constexpr int SC_BUF0 = 0, SC_BUF1 = OPS_BYTES, SC_OB = 2 * OPS_BYTES, OB_ST = 132;
__device__ __forceinline__ void scan_unit(const Args& A, int bh, LAS unsigned char* lds, int tid, int lane, int wave) {
    unsigned char* ws = A.ws; const int b = bh >> 3, h = bh & 7;
    const unsigned char* ops0 = ws + WS_OPS + (size_t)(bh * 32) * OPS_BYTES; const float* UF0 = (const float*)(ws + WS_UF + (size_t)(bh * 32) * UF_BYTES);
    const bf16* GZ0 = (const bf16*)(ws + WS_GZ + (size_t)(bh * 32) * GZ_BYTES); const float* DEC = (const float*)(ws + WS_DEC) + bh * 32 * 32; bf16* YMIX = (bf16*)(ws + WS_YMIX);
    LAS float* Ob = (LAS float*)(lds + SC_OB);
    const bool helper = wave >= 4; const int hw = wave - 4, ht = tid - 256;
#define GDN_DMA(n_) do { const unsigned char* src_ = ops0 + (size_t)(n_) * OPS_BYTES; const int bo_ = ((n_) & 1) ? SC_BUF1 : SC_BUF0; \
        _Pragma("unroll") for (int p_ = 0; p_ < 14; ++p_) __builtin_amdgcn_global_load_lds((const unsigned*)(src_ + (hw * 14 + p_) * 1024 + lane * 16), (LAS unsigned*)(lds + bo_ + (hw * 14 + p_) * 1024), 16, 0, 0); } while (0)
    __syncthreads();
    prep_wait(A, 0, 8, lane);
    __syncthreads();
    if (helper) { GDN_DMA(0); asm volatile("s_waitcnt vmcnt(0)" ::: "memory"); }
    __builtin_amdgcn_s_barrier(); asm volatile("" ::: "memory");
    if (helper) {
        const int tok = ht >> 2, part = ht & 3;
        v4u zA0, zA1, zA2, zA3, zB0, zB1, zB2, zB3;
#define GDN_GZLD(Z0, Z1, Z2, Z3, n_) do { const bf16* gp_ = GZ0 + (size_t)(n_) * 8192 + tok * 128 + 32 * part; \
        asm volatile("global_load_dwordx4 %0, %4, off\n\tglobal_load_dwordx4 %1, %4, off offset:16\n\tglobal_load_dwordx4 %2, %4, off offset:32\n\tglobal_load_dwordx4 %3, %4, off offset:48" \
                     : "=&v"(Z0), "=&v"(Z1), "=&v"(Z2), "=&v"(Z3) : "v"(gp_) : "memory"); } while (0)
#define GDN_HSTEP(n_, Z0, Z1, Z2, Z3) do { \
        asm volatile("" ::: "memory"); __builtin_amdgcn_s_barrier(); asm volatile("" ::: "memory");                         \
        if ((n_) == 0) asm volatile("s_waitcnt vmcnt(4)" ::: "memory"); else if ((n_) < 30) asm volatile("s_waitcnt vmcnt(8)" ::: "memory"); else asm volatile("s_waitcnt vmcnt(0)" ::: "memory"); \
        asm volatile("" : "+v"(Z0), "+v"(Z1), "+v"(Z2), "+v"(Z3)); \
        __builtin_amdgcn_s_barrier(); asm volatile("" ::: "memory");                                                        \
        if ((n_) + 2 < 32) { if ((0x10408100u >> ((n_) + 2)) & 1u) prep_wait(A, (n_) + 2, ((n_) + 2 == 22) ? 6 : ((n_) + 2 == 28) ? 4 : 7, lane);     \
                             GDN_DMA((n_) + 2); } \
        f32x4 o_[8]; float ss_ = 0.f; \
        _Pragma("unroll") for (int i = 0; i < 8; ++i) { o_[i] = *(const LAS f32x4*)(Ob + tok * OB_ST + 32 * part + 4 * i); ss_ += (o_[i].x * o_[i].x + o_[i].y * o_[i].y) + (o_[i].z * o_[i].z + o_[i].w * o_[i].w); } \
        ss_ += __shfl_xor(ss_, 1); ss_ += __shfl_xor(ss_, 2); \
        const float rstd_ = 1.0f / sqrtf(ss_ * (1.0f / 128.0f) + EPS); \
        const unsigned zz_[16] = {Z0.x, Z0.y, Z0.z, Z0.w, Z1.x, Z1.y, Z1.z, Z1.w, Z2.x, Z2.y, Z2.z, Z2.w, Z3.x, Z3.y, Z3.z, Z3.w}; unsigned yw_[16]; \
        _Pragma("unroll") for (int i = 0; i < 8; ++i) { yw_[2 * i] = pk2(o_[i].x * rstd_ * bflo(zz_[2 * i]), o_[i].y * rstd_ * bfhi(zz_[2 * i])); yw_[2 * i + 1] = pk2(o_[i].z * rstd_ * bflo(zz_[2 * i + 1]), o_[i].w * rstd_ * bfhi(zz_[2 * i + 1])); } \
        GAS v4u* yp_ = (GAS v4u*)(YMIX + (size_t)(b * SEQ + (n_) * 64 + tok) * DM + h * 128 + 32 * part); \
        yp_[0] = (v4u){yw_[0], yw_[1], yw_[2], yw_[3]}; yp_[1] = (v4u){yw_[4], yw_[5], yw_[6], yw_[7]}; yp_[2] = (v4u){yw_[8], yw_[9], yw_[10], yw_[11]}; yp_[3] = (v4u){yw_[12], yw_[13], yw_[14], yw_[15]}; \
        asm volatile("" ::: "memory"); \
        if ((n_) + 2 < 32) GDN_GZLD(Z0, Z1, Z2, Z3, (n_) + 2); } while (0)
        GDN_DMA(1); GDN_GZLD(zA0, zA1, zA2, zA3, 0); GDN_GZLD(zB0, zB1, zB2, zB3, 1);
        for (int n = 0; n < 32; n += 2) { GDN_HSTEP(n, zA0, zA1, zA2, zA3); GDN_HSTEP(n + 1, zB0, zB1, zB2, zB3); }
#undef GDN_HSTEP
#undef GDN_GZLD
    } else {
        f32x16 S[4];
#pragma unroll
        for (int i = 0; i < 4; ++i) S[i] = (f32x16){};
        f32x4 u[2][4];
        { const GAS f32x4* up = (const GAS f32x4*)(UF0 + (size_t)(wave * 2) * 1024) + lane;
#pragma unroll
          for (int m2 = 0; m2 < 2; ++m2)
#pragma unroll
              for (int rq = 0; rq < 4; ++rq) u[m2][rq] = up[(m2 * 4 + rq) * 64]; }
        const int w = wave, c = lane & 31, hi = lane >> 5;
        int lz; asm volatile("v_mov_b32 %0, 0" : "=v"(lz));
        float dec_nx = DEC[lz];
#define GDN_SF(kb_, s_) ({ v4u t_; t_.x = pk2(S[kb_][8 * (s_)], S[kb_][8 * (s_) + 1]); t_.y = pk2(S[kb_][8 * (s_) + 2], S[kb_][8 * (s_) + 3]); t_.z = pk2(S[kb_][8 * (s_) + 4], S[kb_][8 * (s_) + 5]); t_.w = pk2(S[kb_][8 * (s_) + 6], S[kb_][8 * (s_) + 7]); __builtin_bit_cast(bf16x8, t_); })
#define GDN_LD44(dst, base_, f0_, f1_) do { _Pragma("unroll") for (int i_ = 0; i_ < 4; ++i_) { dst[i_] = *(const LAS bf16x8*)(buf + (base_) + ((f0_) + i_) * 1024 + lane * 16); dst[4 + i_] = *(const LAS bf16x8*)(buf + (base_) + ((f1_) + i_) * 1024 + lane * 16); } } while (0)
#define GDN_SB() __builtin_amdgcn_sched_barrier(0)
        for (int n = 0; n < 32; ++n) {
            const LAS unsigned char* buf = lds + ((n & 1) ? SC_BUF1 : SC_BUF0);
            const float dec = dec_nx;
            bf16x8 fa[8], fb[8];
            GDN_LD44(fa, WF_OFF, 0, 8); GDN_LD44(fb, WF_OFF, 4, 12); GDN_SB();
            f32x16 vn[2];
#pragma unroll
            for (int m2 = 0; m2 < 2; ++m2) vn[m2] = (f32x16){};
#pragma unroll
            for (int i = 0; i < 4; ++i) { const bf16x8 Sf = GDN_SF(i >> 1, i & 1); vn[0] = __builtin_amdgcn_mfma_f32_32x32x16_bf16(fa[i], Sf, vn[0], 0, 0, 0); vn[1] = __builtin_amdgcn_mfma_f32_32x32x16_bf16(fa[4 + i], Sf, vn[1], 0, 0, 0); }
            GDN_SB(); GDN_LD44(fa, QGF_OFF, 0, 8); GDN_SB();
#pragma unroll
            for (int i = 0; i < 4; ++i) { const bf16x8 Sf = GDN_SF(2 + (i >> 1), i & 1); vn[0] = __builtin_amdgcn_mfma_f32_32x32x16_bf16(fb[i], Sf, vn[0], 0, 0, 0); vn[1] = __builtin_amdgcn_mfma_f32_32x32x16_bf16(fb[4 + i], Sf, vn[1], 0, 0, 0); }
            GDN_SB(); GDN_LD44(fb, QGF_OFF, 4, 12); GDN_SB();
#pragma unroll
            for (int m2 = 0; m2 < 2; ++m2)
#pragma unroll
                for (int rg = 0; rg < 16; ++rg) vn[m2][rg] += u[m2][rg >> 2][rg & 3];
            bf16x8 Vf[2][2];
#pragma unroll
            for (int kb = 0; kb < 2; ++kb)
#pragma unroll
                for (int s = 0; s < 2; ++s) { v4u t; t.x = pk2(vn[kb][8 * s], vn[kb][8 * s + 1]); t.y = pk2(vn[kb][8 * s + 2], vn[kb][8 * s + 3]); t.z = pk2(vn[kb][8 * s + 4], vn[kb][8 * s + 5]); t.w = pk2(vn[kb][8 * s + 6], vn[kb][8 * s + 7]); Vf[kb][s] = __builtin_bit_cast(bf16x8, t); }
            GDN_SB();
            f32x16 o[2];
#pragma unroll
            for (int m2 = 0; m2 < 2; ++m2) o[m2] = (f32x16){};
#pragma unroll
            for (int i = 0; i < 4; ++i) { const bf16x8 Sf = GDN_SF(i >> 1, i & 1); o[0] = __builtin_amdgcn_mfma_f32_32x32x16_bf16(fa[i], Sf, o[0], 0, 0, 0); o[1] = __builtin_amdgcn_mfma_f32_32x32x16_bf16(fa[4 + i], Sf, o[1], 0, 0, 0); }
            GDN_SB(); GDN_LD44(fa, AF_OFF, 0, 4); GDN_SB();
#pragma unroll
            for (int i = 0; i < 4; ++i) { const bf16x8 Sf = GDN_SF(2 + (i >> 1), i & 1); o[0] = __builtin_amdgcn_mfma_f32_32x32x16_bf16(fb[i], Sf, o[0], 0, 0, 0); o[1] = __builtin_amdgcn_mfma_f32_32x32x16_bf16(fb[4 + i], Sf, o[1], 0, 0, 0); }
            GDN_SB(); GDN_LD44(fb, KDF_OFF, 0, 4); GDN_SB();
#pragma unroll
            for (int i = 0; i < 4; ++i) { o[0] = __builtin_amdgcn_mfma_f32_32x32x16_bf16(fa[i], Vf[i >> 1][i & 1], o[0], 0, 0, 0); o[1] = __builtin_amdgcn_mfma_f32_32x32x16_bf16(fa[4 + i], Vf[i >> 1][i & 1], o[1], 0, 0, 0); }
            GDN_SB(); GDN_LD44(fa, KDF_OFF, 8, 12); GDN_SB();
            asm volatile("s_waitcnt lgkmcnt(0)" ::: "memory"); __builtin_amdgcn_s_barrier(); asm volatile("" ::: "memory");
#pragma unroll
            for (int m2 = 0; m2 < 2; ++m2)
#pragma unroll
                for (int rg = 0; rg < 16; ++rg) Ob[(32 * m2 + crow(rg, hi)) * OB_ST + 32 * w + c] = o[m2][rg];
            GDN_SB();
            if (n + 1 < 32) { const GAS f32x4* up = (const GAS f32x4*)(UF0 + (size_t)(n + 1) * 8192 + (size_t)(w * 2) * 1024) + lane;
#pragma unroll
                for (int m2 = 0; m2 < 2; ++m2)
#pragma unroll
                    for (int rq = 0; rq < 4; ++rq) u[m2][rq] = up[(m2 * 4 + rq) * 64];
                dec_nx = DEC[32 * (n + 1) + lz]; }
#pragma unroll
            for (int i = 0; i < 4; ++i) S[i] = S[i] * dec;
#pragma unroll
            for (int i = 0; i < 4; ++i) { S[0] = __builtin_amdgcn_mfma_f32_32x32x16_bf16(fb[i], Vf[i >> 1][i & 1], S[0], 0, 0, 0); S[1] = __builtin_amdgcn_mfma_f32_32x32x16_bf16(fb[4 + i], Vf[i >> 1][i & 1], S[1], 0, 0, 0); }
#pragma unroll
            for (int i = 0; i < 4; ++i) { S[2] = __builtin_amdgcn_mfma_f32_32x32x16_bf16(fa[i], Vf[i >> 1][i & 1], S[2], 0, 0, 0); S[3] = __builtin_amdgcn_mfma_f32_32x32x16_bf16(fa[4 + i], Vf[i >> 1][i & 1], S[3], 0, 0, 0); }
            asm volatile("s_waitcnt lgkmcnt(0)" ::: "memory"); __builtin_amdgcn_s_barrier(); asm volatile("" ::: "memory");
        }
#undef GDN_SF
#undef GDN_LD44
#undef GDN_SB
    }
#undef GDN_DMA
    __syncthreads();
}
}


namespace moba {
constexpr int D = 128, LDK = 7424, LDO = 2048;
constexpr float THR = 8.f; constexpr bool WSKIP = false;
constexpr float SCALE = 0.08838834764831845f;
constexpr int NW = 8, QBLK = 32, KVBLK = 64, QB = NW * QBLK;
constexpr int SHM_V = KVBLK * D * 2, SHM_K = KVBLK * D * 2;
constexpr int LDS_BYTES = 2 * SHM_V + 2 * SHM_K + NW * 64 * 4;
using bf16 = unsigned short;
typedef short bf16x8 __attribute__((ext_vector_type(8)));
typedef short s16x4 __attribute__((ext_vector_type(4)));
typedef float f32x16 __attribute__((ext_vector_type(16)));
typedef float f32x4 __attribute__((ext_vector_type(4)));
typedef unsigned u32x4 __attribute__((ext_vector_type(4)));
template <class A, class Bt> struct same_t { static constexpr bool v = false; };
template <class A> struct same_t<A, A> { static constexpr bool v = true; };
#define KSWZ(row, colB) ((row) * 256 + ((colB) ^ (((row) & 7) << 4)))
#define SBAR() __builtin_amdgcn_sched_barrier(0)
__device__ __forceinline__ int v_st(int k, int c) { const int kk = (k & ~0xC) | ((k & 4) << 1) | ((k & 8) >> 1); return ((kk >> 3) * 4 + (c >> 5)) * 512 + ((kk & 7) * 32 + (c & 31)) * 2; }
__device__ __forceinline__ int v_rd_base(int lane) { return ((lane & 3) << 3) | (((lane >> 2) & 3) << 6) | (((lane >> 4) & 1) << 5) | (((lane >> 5) & 1) << 8); }
constexpr int v_rd_off(int d0, int ks, int half) { return d0 * 512 + ks * 4096 + half * 2048; }
__device__ __forceinline__ int crow(int r, int hi) { return (r & 3) + 8 * (r >> 2) + 4 * hi; }
__device__ __forceinline__ unsigned cvtpk(float lo, float hi) {
    unsigned r; asm volatile("v_cvt_pk_bf16_f32 %0, %1, %2" : "=v"(r) : "v"(lo), "v"(hi)); return r;
}
__device__ __forceinline__ bf16x8 pack8(f32x4 a, f32x4 b) {
    u32x4 w = {cvtpk(a[0], a[1]), cvtpk(a[2], a[3]), cvtpk(b[0], b[1]), cvtpk(b[2], b[3])};
    return *reinterpret_cast<bf16x8*>(&w);
}
template <class T> __device__ __forceinline__ bf16x8 load8(const T* p) {
    if constexpr (same_t<T, float>::v) { return pack8(*(const f32x4*)p, *(const f32x4*)(p + 4)); }
    else { return *reinterpret_cast<const bf16x8*>(p); }
}
__device__ __forceinline__ void mask_tile(f32x16& p0, f32x16& p1, int dq, unsigned W) {
    const float NEG = -__builtin_inff();
#pragma unroll
    for (int r = 0; r < 16; ++r) {
        const int c = (r & 3) + 8 * (r >> 2);
        if ((unsigned)(dq - c) >= W) p0[r] = NEG;
        if ((unsigned)(dq - c - 32) >= W) p1[r] = NEG;
    }
}
__device__ __forceinline__ void partialSM(f32x16& p0, f32x16& p1, float& m_reg, float& mn, float& alpha) {
    float pmax = p0[0]; for (int r = 1; r < 16; ++r) pmax = fmaxf(pmax, p0[r]); for (int r = 0; r < 16; ++r) pmax = fmaxf(pmax, p1[r]);
    { auto rr = __builtin_amdgcn_permlane32_swap(__float_as_uint(pmax), __float_as_uint(pmax), false, false);
      pmax = fmaxf(__uint_as_float(rr[0]), __uint_as_float(rr[1])); }
    constexpr float C2 = 1.4426950408889634f * SCALE;
    if (__builtin_expect(__all((pmax - m_reg) * SCALE <= THR), 1)) { mn = m_reg; alpha = 1.f; }
    else { mn = fmaxf(m_reg, pmax); alpha = __builtin_amdgcn_exp2f((m_reg - mn) * C2); m_reg = mn; }
    const float mnL = -mn * C2;
    for (int r = 0; r < 16; ++r) p0[r] = fmaf(p0[r], C2, mnL); for (int r = 0; r < 16; ++r) p1[r] = fmaf(p1[r], C2, mnL);
    for (int r = 0; r < 16; ++r) p0[r] = __builtin_amdgcn_exp2f(p0[r]);
}
__device__ __forceinline__ void finishSM(f32x16& p0, f32x16& p1, float alpha, float& l_reg, bf16x8& pa0, bf16x8& pa1, bf16x8& pa2, bf16x8& pa3) {
    for (int r = 0; r < 16; ++r) p1[r] = __builtin_amdgcn_exp2f(p1[r]);
    float ps = 0; for (int r = 0; r < 16; ++r) ps += p0[r]; for (int r = 0; r < 16; ++r) ps += p1[r];
    { auto rr = __builtin_amdgcn_permlane32_swap(__float_as_uint(ps), __float_as_uint(ps), false, false);
      ps = __uint_as_float(rr[0]) + __uint_as_float(rr[1]); }
    l_reg = l_reg * alpha + ps;
#define PK4(P, B_, OUT) do { unsigned a0 = cvtpk(P[B_+0], P[B_+1]), a1 = cvtpk(P[B_+2], P[B_+3]);                          \
        unsigned b0 = cvtpk(P[B_+4], P[B_+5]), b1 = cvtpk(P[B_+6], P[B_+7]);                                             \
        auto r0 = __builtin_amdgcn_permlane32_swap(a0, b0, false, false); auto r1 = __builtin_amdgcn_permlane32_swap(a1, b1, false, false); \
        u32x4 w = {r0[0], r1[0], r0[1], r1[1]}; OUT = *reinterpret_cast<bf16x8*>(&w); } while (0)
    PK4(p0, 0, pa0); PK4(p0, 8, pa1); PK4(p1, 0, pa2); PK4(p1, 8, pa3);
#undef PK4
}
template <int KB, bool SK>
__device__ __forceinline__ void qkt(f32x16& p0, f32x16& p1, const char* K_lds, int r32, int hi, const bf16x8* qr, bool act) {
    if (SK && !act) { const float NEG = -__builtin_inff();
#pragma unroll
        for (int r = 0; r < 16; ++r) { p0[r] = NEG; p1[r] = NEG; } return; }
    p0 = f32x16{}; p1 = f32x16{};
    const char* kb[4];
#pragma unroll
    for (int dd = 0; dd < 4; ++dd) kb[dd] = K_lds + KB * SHM_K + KSWZ(r32, (dd * 16 + hi * 8) * 2);
#pragma unroll
    for (int d0 = 0; d0 < 8; ++d0) { const char* a = kb[d0 & 3] + (d0 >> 2) * 128;
        bf16x8 b0 = *reinterpret_cast<const bf16x8*>(a);
        bf16x8 b1 = *reinterpret_cast<const bf16x8*>(a + 32 * 256);
        p0 = __builtin_amdgcn_mfma_f32_32x32x16_bf16(b0, qr[d0], p0, 0, 0, 0);
        p1 = __builtin_amdgcn_mfma_f32_32x32x16_bf16(b1, qr[d0], p1, 0, 0, 0); }
}
template <int VB, bool SK>
__device__ __forceinline__ void pv_tile(f32x16* o, int vb0, bf16x8 pa0, bf16x8 pa1, bf16x8 pa2, bf16x8 pa3, bool act) {
    if (SK && !act) return;
#define TRRD(dst, off) asm volatile("ds_read_b64_tr_b16 %0, %1 offset:%2" : "=&v"(dst) : "v"(vb0), "i"(off) : "memory")
#define PV_D0(d0) do { s16x4 l0, l1, l2, l3, h0, h1, h2, h3; constexpr int b_ = VB * SHM_V + v_rd_off(d0, 0, 0);     \
        TRRD(l0, b_); TRRD(h0, b_ + 2048); TRRD(l1, b_ + 4096); TRRD(h1, b_ + 6144); TRRD(l2, b_ + 8192); TRRD(h2, b_ + 10240); TRRD(l3, b_ + 12288); TRRD(h3, b_ + 14336); \
        asm volatile("s_waitcnt lgkmcnt(0)" ::: "memory"); SBAR();                 \
        o[d0] = __builtin_amdgcn_mfma_f32_32x32x16_bf16(pa0, (bf16x8){l0[0], l0[1], l0[2], l0[3], h0[0], h0[1], h0[2], h0[3]}, o[d0], 0, 0, 0);   \
        o[d0] = __builtin_amdgcn_mfma_f32_32x32x16_bf16(pa1, (bf16x8){l1[0], l1[1], l1[2], l1[3], h1[0], h1[1], h1[2], h1[3]}, o[d0], 0, 0, 0);   \
        o[d0] = __builtin_amdgcn_mfma_f32_32x32x16_bf16(pa2, (bf16x8){l2[0], l2[1], l2[2], l2[3], h2[0], h2[1], h2[2], h2[3]}, o[d0], 0, 0, 0);   \
        o[d0] = __builtin_amdgcn_mfma_f32_32x32x16_bf16(pa3, (bf16x8){l3[0], l3[1], l3[2], l3[3], h3[0], h3[1], h3[2], h3[3]}, o[d0], 0, 0, 0); } while (0)
    PV_D0(0); PV_D0(1); PV_D0(2); PV_D0(3);
#undef PV_D0
#undef TRRD
}

template <class TIn, class TOut> struct BlockRef { const TIn* Q; const TIn* K; const TIn* V; TOut* O; int P0; };
template <class TIn> struct Seam {
    bf16x8 qr[8];
    bf16x8 st_v0, st_v1, st_k0, st_k1; f32x4 sf0, sf1, sf2, sf3;
    f32x4 tq[16];
};
__device__ __forceinline__ int swa_jlo(int P0, int W) { const int lowk = P0 - W + 1; return lowk > 0 ? lowk / KVBLK : 0; }
#define ROW(p, k0, rr) ((p) + (size_t)((k0) + (rr)) * LDK + sc)
#define VMW() asm volatile("s_waitcnt vmcnt(0)" ::: "memory")
#define VMWN(n) asm volatile("s_waitcnt vmcnt(%0)" :: "i"(n) : "memory")
#define SLOAD_H(Kp, Vp, k0) do { S.st_v0 = load8<TIn>(ROW(Vp, k0, sr)); S.st_v1 = load8<TIn>(ROW(Vp, k0, 32 + sr));              \
                         S.st_k0 = load8<TIn>(ROW(Kp, k0, sr)); S.st_k1 = load8<TIn>(ROW(Kp, k0, 32 + sr)); } while (0)
#define SWRITE_HK(bf) do { *(bf16x8*)(K_lds + (bf) * SHM_K + kws) = S.st_k0; *(bf16x8*)(K_lds + (bf) * SHM_K + kws + 32 * 256) = S.st_k1; } while (0)
#define SWRITE_HV(bf) do { *(bf16x8*)(V_lds + (bf) * SHM_V + vst0) = S.st_v0; *(bf16x8*)(V_lds + (bf) * SHM_V + vst1) = S.st_v1; } while (0)
#define SWRITE_H(bf) do { SWRITE_HV(bf); SWRITE_HK(bf); } while (0)
#define SLOAD_F(p, k0) do { S.sf0 = *(const f32x4*)ROW(p, k0, sr); S.sf1 = *(const f32x4*)(ROW(p, k0, sr) + 4);                \
                            S.sf2 = *(const f32x4*)ROW(p, k0, 32 + sr); S.sf3 = *(const f32x4*)(ROW(p, k0, 32 + sr) + 4); } while (0)
#define SWRITE_KF(bf) do { *(bf16x8*)(K_lds + (bf) * SHM_K + kws) = pack8(S.sf0, S.sf1); *(bf16x8*)(K_lds + (bf) * SHM_K + kws + 32 * 256) = pack8(S.sf2, S.sf3); } while (0)
#define SWRITE_VF(bf) do { *(bf16x8*)(V_lds + (bf) * SHM_V + vst0) = pack8(S.sf0, S.sf1); *(bf16x8*)(V_lds + (bf) * SHM_V + vst1) = pack8(S.sf2, S.sf3); } while (0)
template <class TIn, class TOut>
__device__ __forceinline__ void causal_swa_prime(const BlockRef<TIn, TOut>& cur, int W, char* lds, Seam<TIn>& S) {
    constexpr bool F32 = same_t<TIn, float>::v;
    const int tid = threadIdx.x, wid = __builtin_amdgcn_readfirstlane(tid >> 6), lane = tid & 63, r32 = lane & 31, hi = lane >> 5;
    const int sr = tid >> 4, sc = (tid & 15) * 8, kws = KSWZ(sr, sc * 2); char* K_lds = lds + 2 * SHM_V;
    const int kb0 = swa_jlo(cur.P0, W) * KVBLK;
    for (int d0 = 0; d0 < 8; ++d0) S.qr[d0] = load8<TIn>(cur.Q + (size_t)(wid * QBLK + r32) * LDK + d0 * 16 + hi * 8);
    if constexpr (F32) { SLOAD_F((const float*)cur.K, kb0); VMW(); SWRITE_KF(0); SBAR(); SLOAD_F((const float*)cur.V, kb0); }
    else { SLOAD_H(cur.K, cur.V, kb0); VMW(); SWRITE_HK(0); }
    __syncthreads();
}
template <class TIn, class TOut>
__device__ __forceinline__ void causal_swa_block(const BlockRef<TIn, TOut>& cur, const BlockRef<TIn, TOut>& nxt, int skv, int W, char* lds, Seam<TIn>& S, const unsigned pm) {
    const int own_blk = cur.P0 >> 8;
    constexpr bool F32 = same_t<TIn, float>::v;
    const int tid = threadIdx.x, wid = __builtin_amdgcn_readfirstlane(tid >> 6), lane = tid & 63, r32 = lane & 31, hi = lane >> 5;
    const int j_lo = swa_jlo(cur.P0, W);
    int j_hi = (cur.P0 + QB - 1) / KVBLK + 1; if (j_hi > skv / KVBLK) j_hi = skv / KVBLK;
    const int NT = j_hi - j_lo;
    const int kbn = swa_jlo(nxt.P0, W) * KVBLK;
    const int qlo = cur.P0 + wid * QBLK, qm = qlo + r32 - 4 * hi;
    char* V_lds = lds; char* K_lds = lds + 2 * SHM_V;
    float* ws = (float*)(lds + 2 * SHM_V + 2 * SHM_K) + wid * 64; float* li_l = ws, * al_l = ws + 32;
    float m_reg = -1e30f, l_reg = 0; f32x16 o[4] = {};
    const int sr = tid >> 4, sc = (tid & 15) * 8, vst0 = v_st(sr, sc), vst1 = v_st(32 + sr, sc), kws = KSWZ(sr, sc * 2);
    const int vb0 = (int)(uintptr_t)V_lds + v_rd_base(lane);
    const TIn* Kh = cur.K; const TIn* Vh = cur.V;
#define RESC(a) do { if (__any((a) < 1.f)) { if (hi == 0) al_l[r32] = (a); asm volatile("s_waitcnt lgkmcnt(0)" ::: "memory");              \
                     for (int d_ = 0; d_ < 4; ++d_) for (int r = 0; r < 16; ++r) o[d_][r] *= al_l[crow(r, hi)]; } } while (0)
#define KBASE(t) ((j_lo + (t)) * KVBLK)
#define ACT(t) (KBASE(t) <= qlo + QBLK - 1 && KBASE(t) + KVBLK - 1 >= qlo - W + 1)
#define MASKT(P0_, P1_, t) do { const int kb_ = KBASE(t); if ((!SK || ACT(t)) && (kb_ + KVBLK - 1 > qlo || kb_ <= qlo + QBLK - 1 - W)) mask_tile(P0_, P1_, qm - kb_, (unsigned)W); if ((kb_ >> 8) < own_blk) { if (!((pm >> (kb_ >> 8)) & 1u)) { const float NEG_ = -__builtin_inff(); _Pragma("unroll") for (int r_ = 0; r_ < 16; ++r_) { P0_[r_] = NEG_; P1_[r_] = NEG_; } } } } while (0)
    constexpr int NQL = F32 ? 16 : 8;
    constexpr bool SK = WSKIP && !F32;
#define SEAM_K0() do { VMWN(NQL); if constexpr (F32) { SWRITE_KF(0); SBAR(); SLOAD_F((const float*)nxt.V, kbn); } else { SWRITE_HK(0); } SBAR(); } while (0)
    f32x16 pA0, pA1, pB0, pB1; float mnA, mnB, alA, alB; bf16x8 pa0, pa1, pa2, pa3;
    if constexpr (F32) { VMW(); SWRITE_VF(0); SBAR(); } else { SWRITE_HV(0); SBAR(); }
    if (NT > 1) { if constexpr (F32) SLOAD_F((const float*)Kh, KBASE(1)); else SLOAD_H(Kh, Vh, KBASE(1)); }
    SBAR(); qkt<0, SK>(pA0, pA1, K_lds, r32, hi, S.qr, ACT(0));
    if constexpr (F32) { if (NT > 1) { VMW(); SWRITE_KF(1); SBAR(); SLOAD_F((const float*)Vh, KBASE(1)); } }
    MASKT(pA0, pA1, 0); partialSM(pA0, pA1, m_reg, mnA, alA);
    if (NT > 1) { VMW(); if constexpr (F32) { SWRITE_VF(1); SBAR(); if (NT > 2) SLOAD_F((const float*)Kh, KBASE(2)); } else SWRITE_H(1); }
    __syncthreads();
#define HALF_STEP(PX0, PX1, mnX, alX, PY0, PY1, alY, t, KB, VB, SB) do {                                                      \
        SBAR(); qkt<KB, SK>(PX0, PX1, K_lds, r32, hi, S.qr, ACT(t));                                             \
        finishSM(PY0, PY1, alY, l_reg, pa0, pa1, pa2, pa3); SBAR();                                                           \
        if ((t) + 1 < NT) { if constexpr (F32) { VMW(); SWRITE_KF(SB); SBAR(); SLOAD_F((const float*)Vh, KBASE((t) + 1)); }  \
                            else { SLOAD_H(Kh, Vh, KBASE((t) + 1)); } SBAR(); }                                               \
        pv_tile<VB, SK>(o, vb0, pa0, pa1, pa2, pa3, ACT((t) - 1)); MASKT(PX0, PX1, (t)); partialSM(PX0, PX1, m_reg, mnX, alX);                                        \
        __syncthreads();                                                                                                      \
        if ((t) + 1 < NT) { VMW(); if constexpr (F32) { SWRITE_VF(SB); SBAR(); if ((t) + 2 < NT) SLOAD_F((const float*)Kh, KBASE((t) + 2)); } \
                            else { SWRITE_H(SB); } }                                                                          \
        RESC(alX); __syncthreads(); } while (0)
    for (int t = 1; t + 1 < NT; t += 2) {
        HALF_STEP(pB0, pB1, mnB, alB, pA0, pA1, alA, t, 1, 0, 0);
        HALF_STEP(pA0, pA1, mnA, alA, pB0, pB1, alB, t + 1, 0, 1, 1);
    }
    const bool even = (NT & 1) == 0;
    if (even) { SBAR(); qkt<1, SK>(pB0, pB1, K_lds, r32, hi, S.qr, ACT(NT - 1)); SBAR(); }
#define QROW(e) (nxt.Q + (size_t)(wid * QBLK + r32) * LDK + ((e) >> 1) * 16 + hi * 8 + ((e) & 1) * 4)
    if constexpr (F32) { SLOAD_F((const float*)nxt.K, kbn); SBAR();
#pragma unroll
        for (int e = 0; e < 8; ++e) S.tq[e] = *(const f32x4*)QROW(e); }
    else { SLOAD_H(nxt.K, nxt.V, kbn); SBAR();
#pragma unroll
        for (int d0 = 0; d0 < 8; ++d0) S.qr[d0] = load8<TIn>(nxt.Q + (size_t)(wid * QBLK + r32) * LDK + d0 * 16 + hi * 8); }
    SBAR();
    finishSM(pA0, pA1, alA, l_reg, pa0, pa1, pa2, pa3); SBAR();
    if constexpr (F32) {
#pragma unroll
        for (int e = 8; e < 16; ++e) S.tq[e] = *(const f32x4*)QROW(e); SBAR(); }
#undef QROW
    pv_tile<0, SK>(o, vb0, pa0, pa1, pa2, pa3, ACT(even ? NT - 2 : NT - 1));
    if (even) { MASKT(pB0, pB1, NT - 1); partialSM(pB0, pB1, m_reg, mnB, alB); __syncthreads(); RESC(alB);
        finishSM(pB0, pB1, alB, l_reg, pa0, pa1, pa2, pa3); SBAR(); pv_tile<1, SK>(o, vb0, pa0, pa1, pa2, pa3, ACT(NT - 1)); }
    SBAR(); SEAM_K0();
    if (hi == 0) li_l[r32] = l_reg; asm volatile("s_waitcnt lgkmcnt(0)" ::: "memory");
    float rli[16];
#pragma unroll
    for (int r = 0; r < 16; ++r) rli[r] = __builtin_amdgcn_rcpf(li_l[crow(r, hi)]);
    TOut* Ow = cur.O + (size_t)(wid * QBLK) * LDO;
#pragma unroll
    for (int r = 0; r < 16; ++r) { const int orow = crow(r, hi);
#pragma unroll
        for (int d0 = 0; d0 < 4; ++d0) { const float v = o[d0][r] * rli[r];
            if constexpr (same_t<TOut, float>::v) { Ow[(size_t)orow * LDO + d0 * 32 + r32] = v; }
            else { const float vn = __shfl_xor(v, 1);
                   if ((r32 & 1) == 0) *(unsigned*)(Ow + (size_t)orow * LDO + d0 * 32 + r32) = cvtpk(v, vn); } } }
    if constexpr (F32) {
#pragma unroll
        for (int d0 = 0; d0 < 8; ++d0) S.qr[d0] = pack8(S.tq[2 * d0], S.tq[2 * d0 + 1]); }
    __syncthreads();
#undef RESC
#undef KBASE
#undef ACT
#undef MASKT
#undef SEAM_K0
#undef HALF_STEP
}
#undef ROW
#undef VMW
#undef VMWN
#undef SLOAD_H
#undef SWRITE_HK
#undef SWRITE_HV
#undef SWRITE_H
#undef SLOAD_F
#undef SWRITE_KF
#undef SWRITE_VF
__device__ __forceinline__ unsigned select_mask(const bf16x8* qr, const float* km  , int own, int hi) {
    float gate[7];
#pragma unroll
    for (int n = 0; n < 7; ++n) { float p = 0.f;
        if (n < own) {
#pragma unroll
            for (int d0 = 0; d0 < 8; ++d0) { const f32x4 k0 = *(const f32x4*)(km + n * 128 + d0 * 16 + hi * 8), k1 = *(const f32x4*)(km + n * 128 + d0 * 16 + hi * 8 + 4); const bf16x8 q = qr[d0];
                p += __builtin_bit_cast(float, (unsigned)(unsigned short)q[0] << 16) * k0[0] + __builtin_bit_cast(float, (unsigned)(unsigned short)q[1] << 16) * k0[1]
                   + __builtin_bit_cast(float, (unsigned)(unsigned short)q[2] << 16) * k0[2] + __builtin_bit_cast(float, (unsigned)(unsigned short)q[3] << 16) * k0[3]
                   + __builtin_bit_cast(float, (unsigned)(unsigned short)q[4] << 16) * k1[0] + __builtin_bit_cast(float, (unsigned)(unsigned short)q[5] << 16) * k1[1]
                   + __builtin_bit_cast(float, (unsigned)(unsigned short)q[6] << 16) * k1[2] + __builtin_bit_cast(float, (unsigned)(unsigned short)q[7] << 16) * k1[3]; }
            p += __shfl_xor(p, 32); }
        gate[n] = (n < own) ? p : -__builtin_inff(); }
    unsigned pm = 0u;
#pragma unroll
    for (int r = 0; r < 3; ++r) { if (r < own) { int best = 0; float bv = -__builtin_inff(); bool have = false;
#pragma unroll
            for (int n = 0; n < 7; ++n) { const bool cand = (n < own) && !((pm >> n) & 1u); if (cand && (!have || gate[n] > bv)) { bv = gate[n]; best = n; have = true; } }
            pm |= 1u << best; } }
    return pm;
}
__device__ __forceinline__ int moba_units(int c, int& bh, int& q0, int& q1) { bh = c / 6; const int s = c % 6; if (s < 4) { q0 = q1 = 7 - s; return 1; } if (s == 4) { q0 = 0; q1 = 3; } else { q0 = 1; q1 = 2; } return 2; }
__device__ __forceinline__ BlockRef<bf16, bf16> moba_ref(const bf16* PROJ, bf16* YMIX, int bh, int qb) {
    const int b = bh >> 3, h = bh & 7; BlockRef<bf16, bf16> r;
    r.Q = PROJ + (size_t)(b * 2048 + qb * QB) * LDK + 4096 + h * 128; r.K = PROJ + (size_t)(b * 2048) * LDK + 5120 + h * 128; r.V = PROJ + (size_t)(b * 2048) * LDK + 6144 + h * 128;
    r.O = YMIX + (size_t)(b * 2048 + qb * QB) * LDO + 1024 + h * 128; r.P0 = qb * QB; return r;
}
__device__ __forceinline__ void moba_phase(int c, const bf16* PROJ, bf16* YMIX, const float* KM, char* lds) {
    int bh, q0, q1; const int nu = moba_units(c, bh, q0, q1); const int hi = (threadIdx.x & 63) >> 5;
    const float* km = KM + (size_t)bh * 8 * 128;
    BlockRef<bf16, bf16> cur = moba_ref(PROJ, YMIX, bh, q0);
    Seam<bf16> S;
    causal_swa_prime<bf16, bf16>(cur, 1 << 20, lds, S);
    for (int u = 0; u < nu; ++u) {
        const BlockRef<bf16, bf16> nxt = (u + 1 < nu) ? moba_ref(PROJ, YMIX, bh, q1) : cur;
        const unsigned pm = select_mask(S.qr, km, cur.P0 >> 8, hi);
        causal_swa_block<bf16, bf16>(cur, nxt, 2048, 1 << 20, lds, S, pm);
        cur = nxt;
    }
}
}

constexpr int N_PHASES = 12;
__global__ void __launch_bounds__(NTHR, 2) mk_fwd(Args args) {
    extern __shared__ __attribute__((aligned(16))) unsigned char lds_raw[];
    LAS unsigned char* lds = (LAS unsigned char*)lds_raw;
    volatile LAS unsigned* MISC = (volatile LAS unsigned*)(lds + MISC_OFF);
    const int tid = threadIdx.x, lane = tid & 63, wave = __builtin_amdgcn_readfirstlane(tid >> 6);
    const int G = gridDim.x; const int bx = blockIdx.x; const int vcu = (G % 8 == 0) ? (bx % 8) * (G / 8) + bx / 8 : bx;
    const int gw = vcu * NWAVES + wave, NGW = G * NWAVES;
    unsigned char* ws = args.ws; gu32* ctl = (gu32*)(ws + WS_CTL);
    for (int u = tid; u < (LDS_BYTES - LDSCTL_OFF) / 4; u += NTHR) ((LAS unsigned*)(lds + LDSCTL_OFF))[u] = 0u;
    __syncthreads();
    const int lo = args.ph_lo, hi = args.ph_hi;
    const bool one_launch = (hi - lo) > 1;
    XcdBarrier bar; bar.bar = (unsigned*)(ctl + CW_BAR) + args.li * XCD_BAR_WORDS; bar.x = 0; bar.st = nullptr;
    if (one_launch) bar = xcd_barrier_post((unsigned*)(ctl + CW_BAR) + args.li * XCD_BAR_WORDS, MISC + 8);
#define IN(k) (lo <= (k) && (k) < hi)
#define SEAM(k) do { if (IN(k) && IN((k) + 1)) xcd_barrier(bar); } while (0)
    float* mod = (float*)(ws + WS_MOD); bf16* H = (bf16*)(ws + WS_H); bf16* ACT = (bf16*)(ws + WS_ACT); float* Y = (float*)(ws + WS_Y); bf16* PROJ = (bf16*)(ws + WS_PROJ); bf16* YMIX = (bf16*)(ws + WS_YMIX);

    if (IN(0)) { rope_table(args, tid); fill_slot(args, lds, tid, lane, wave, bx, G, -1, 128, VI_F1, VI_IN, 3968); adaln_wait(args, 128u, tid);
                 row_pass_first(args, lds, H, gw, NGW, tid, lane); } SEAM(0);
    if (IN(2)) { pg8::Gemm g{H, (const bf16*)(ws + WS_WGU1), M, NGU, DM}; pg8::StaticOrder S; S.init(M, NGU, G, bx); pg8::EpiSwiGLU E{ACT, DFF};
                 pg8::gemm_phase<pg8::EpiSwiGLU, pg8::StaticOrder, true, true>(lds + RING_OFF, g, S, E);
                 if (G == 256 && bx >= 128) fill_slot(args, lds, tid, lane, wave, bx - 128, 128, 32, 48, VI_IN, VI_OUT, 0); } SEAM(2);
    if (IN(3)) { pg8::Gemm g{ACT, (const bf16*)(ws + WS_WD1), M, DM, DFF}; pg8::StaticOrder S; S.init(M, DM, G, bx);
                 pg8::PanelSS s1{(float*)(ws + WS_XB), (unsigned*)(ctl + CW_PAN)}, s2{(float*)(ws + WS_XB) + 65536, (unsigned*)(ctl + CW_PAN + 2048)};
                 pg8::EpiNormRes<false, true> E{args.in[I_X], ws + WS_XRES, H, mod, args.in[I_F1POST], 2, 0.5f, args.in[I_MPRE], 3, 4, s1, s2};
                 pg8::gemm_phase<pg8::EpiNormRes<false, true>, pg8::StaticOrder, false, true>(lds + RING_OFF, g, S, E); } SEAM(3);
    if (IN(5)) { pg8::Gemm g{H, (const bf16*)(ws + WS_WIN), M, NIN, DM}; pg8::StaticOrder S; S.init(M, NIN, G, bx); pg8::EpiBf16 E{PROJ, NIN};
                 pg8::gemm_phase<pg8::EpiBf16, pg8::StaticOrder, true, true>(lds + RING_OFF, g, S, E);
                 if (G == 256 && bx >= 160) fill_slot(args, lds, tid, lane, wave, bx - 160, 96, 80, 48, VI_F2GU, VI_F2GU + 2112, 96 * NWAVES); } SEAM(5);
    const bool scan_wg = (bx >= 192 && bx < 224); const int prk = bx < 192 ? bx : bx - 32; const int s6 = bx % 6; const int pquota = bx >= 224 ? 5 : (scan_wg ? 1 : (s6 == 0 ? 3 : (s6 < 3 ? 4 : 5)));
#define PREP_IDX(k_) ((k_) == 0 ? bx : (k_) < 3 ? 32 + 224 * (k_) + prk : (k_) == 3 ? 704 + (bx < 192 ? (bx / 6) * 5 + (s6 - 1) : bx - 64) : 896 + (bx < 192 ? (bx / 6) * 3 + (s6 - 3) : bx - 128))
#define PREP_REC(i_) (((i_) & 31) * 32 + ((i_) >> 5))
    constexpr int FR2 = VI_F2GU + 2112;
    if (IN(6)) { if (wave >= 4) gdn::prep_touch(args, PREP_REC(bx), tid - 256);
                 }
    if (IN(7)) { __syncthreads();
                 if (!(args.norope & 1)) { rope_q_phase(args, gw, NGW, lane); for (int it = bx; it < NB * 8 * 8; it += G) krope_kmean_item(args, it, lds, tid); }
                 asm volatile("s_waitcnt vmcnt(0)" ::: "memory"); __syncthreads();
                 if (tid == 0) { __builtin_amdgcn_fence(__ATOMIC_RELEASE, "agent"); asm volatile("s_waitcnt vmcnt(0)" ::: "memory"); __hip_atomic_fetch_add((gu32*)(ws + WS_CTL) + CW_ROPE, 1u, __ATOMIC_RELAXED, __HIP_MEMORY_SCOPE_AGENT); }
                 { int pub = -1;
                     for (int k = 0; k < pquota; ++k) { const int idx = PREP_IDX(k); const int nxt = (k + 1 < pquota) ? PREP_REC(PREP_IDX(k + 1)) : -1;
                         gdn::prep_item(args, PREP_REC(idx), nxt, pub, idx, lds, tid, lane, wave); pub = idx >> 5; }
                     asm volatile("s_waitcnt vmcnt(0)" ::: "memory"); __syncthreads();
                     if (tid == 0) __hip_atomic_fetch_add((gu32*)(ws + WS_CTL) + CW_PREP + 16 * pub, 1u, __ATOMIC_RELAXED, __HIP_MEMORY_SCOPE_AGENT);
                     __syncthreads(); }
                 if (bx < 192) { if (tid == 0) { unsigned sp = 0; while (__hip_atomic_load((gu32*)(ws + WS_CTL) + CW_ROPE, __ATOMIC_RELAXED, __HIP_MEMORY_SCOPE_AGENT) < (unsigned)G) { __builtin_amdgcn_s_sleep(4); if (++sp > (1u << 22)) break; }
                                                 __builtin_amdgcn_fence(__ATOMIC_ACQUIRE, "agent"); asm volatile("s_waitcnt vmcnt(0)" ::: "memory"); }
                                 __syncthreads();
                                 if (!(args.norope & 2)) moba::moba_phase(bx, (const bf16*)PROJ, YMIX, (const float*)(ws + WS_KMEAN), (char*)lds_raw);
                                 }
                 else if (bx < 224) { if (!(args.norope & 4)) gdn::scan_unit(args, bx - 192, lds, tid, lane, wave); }
                 else if (G == 256 && !(args.norope & 8)) fill_slot(args, lds, tid, lane, wave, bx - 224, 32, 0, 0, FR2, FR2 + 704, 704); } SEAM(7);
    if (IN(8)) { pg8::Gemm g{YMIX, (const bf16*)(ws + WS_WOUT), M, DM, DM}; pg8::StaticOrder S; S.init(M, DM, G, bx);
                 pg8::PanelSS s1{(float*)(ws + WS_XB) + 2 * 65536, (unsigned*)(ctl + CW_PAN + 2 * 2048)}, s2{(float*)(ws + WS_XB) + 3 * 65536, (unsigned*)(ctl + CW_PAN + 3 * 2048)};
                 pg8::EpiNormRes<true, true> E{ws + WS_XRES, ws + WS_XRES, H, mod, args.in[I_MPOST], 5, 1.0f, args.in[I_F2PRE], 6, 7, s1, s2};
                 pg8::gemm_phase<pg8::EpiNormRes<true, true>, pg8::StaticOrder, false, true>(lds + RING_OFF, g, S, E); } SEAM(8);
    if (IN(10)) { pg8::Gemm g{H, (const bf16*)(ws + WS_WGU2), M, NGU, DM}; pg8::StaticOrder S; S.init(M, NGU, G, bx); pg8::EpiSwiGLU E{ACT, DFF};
                  pg8::gemm_phase<pg8::EpiSwiGLU, pg8::StaticOrder, true, true>(lds + RING_OFF, g, S, E);
                  if (G == 256 && bx >= 128) fill_slot(args, lds, tid, lane, wave, bx - 128, 128, 128, 16, VI_F2D, VI_END, 2 * 128 * NWAVES); } SEAM(10);
    if (IN(11)) { pg8::Gemm g{ACT, (const bf16*)(ws + WS_WD2), M, DM, DFF}; pg8::StaticOrder S; S.init(M, DM, G, bx);
                  pg8::PanelSS s1{(float*)(ws + WS_XB) + 4 * 65536, (unsigned*)(ctl + CW_PAN + 4 * 2048)};
                  pg8::EpiNormRes<true, false> E{ws + WS_XRES, args.out, nullptr, mod, args.in[I_F2POST], 8, 0.5f, nullptr, 0, 0, s1, s1};
                  pg8::gemm_phase<pg8::EpiNormRes<true, false>, pg8::StaticOrder, false, true>(lds + RING_OFF, g, S, E); }
#undef IN
#undef SEAM
#undef PREP_IDX
#undef PREP_REC
}

extern "C" void kernel_launch(void* const* d_in, const int* in_sizes, int n_in, void* d_out, int out_size, void* d_ws, size_t ws_size, hipStream_t stream) {
    static int grid = 0;
    if (grid == 0) {
        if (n_in != 22 || out_size != M * DM || ws_size < WS_END) { fprintf(stderr, "kernel_launch: unexpected shapes (n_in %d out %d ws %zu)\n", n_in, out_size, ws_size); grid = -1; return; }
        int dev = 0, cus = 0, per_cu = 0;
        if (hipGetDevice(&dev) != hipSuccess || hipDeviceGetAttribute(&cus, hipDeviceAttributeMultiprocessorCount, dev) != hipSuccess) { grid = -1; return; }
        if (hipFuncSetAttribute((const void*)mk_fwd, hipFuncAttributeMaxDynamicSharedMemorySize, LDS_BYTES) != hipSuccess) { fprintf(stderr, "kernel_launch: hipFuncSetAttribute failed\n"); grid = -1; return; }
        if (hipOccupancyMaxActiveBlocksPerMultiprocessor(&per_cu, (const void*)mk_fwd, NTHR, LDS_BYTES) != hipSuccess || per_cu < 1) { fprintf(stderr, "kernel_launch: occupancy query says %d blocks per CU\n", per_cu); per_cu = 1; }
        (void)hipGetLastError();
        grid = cus;
    }
    if (grid < 0) return;
    (void)hipMemsetAsync((char*)d_ws + WS_CTL, 0, CTL_ZERO_BYTES, stream);
    Args a{};
    for (int i = 0; i < 22; ++i) a.in[i] = (const float*)d_in[i];
    a.out = (float*)d_out; a.ws = (unsigned char*)d_ws;
#ifndef PROBE_FLAGS
#define PROBE_FLAGS 0
#endif
#if defined(PROBE_A_LO)
    a.ph_lo = 0; a.ph_hi = PROBE_A_HI; a.li = 0; a.norope = 0; hipLaunchKernelGGL(mk_fwd, dim3(grid), dim3(NTHR), LDS_BYTES, stream, a);
    a.ph_lo = PROBE_A_LO; a.ph_hi = N_PHASES; a.li = 1; a.norope = ((PROBE_A_LO <= 6 && 6 < PROBE_A_HI) ? 1 : 0) | PROBE_FLAGS; hipLaunchKernelGGL(mk_fwd, dim3(grid), dim3(NTHR), LDS_BYTES, stream, a);
#else
    a.ph_lo = 0; a.ph_hi = N_PHASES; a.li = 0; a.norope = 0; hipLaunchKernelGGL(mk_fwd, dim3(grid), dim3(NTHR), LDS_BYTES, stream, a);
#endif
}
```
